# Optimizing an MI355X kernel written in HIP

```python
import jax, jax.numpy as jnp
from jax import lax
import numpy as np

D_MODEL = 1024
BATCH = 32
SEQ = 256
DEPTH = 2
DEC_BATCH = 4
DEC_SEQ = 2048
PAST_LEN = 256

GRID_W = 64
MLA_HEADS = 8
Q_LORA = 256
KV_LORA = 128
QK_NOPE = 64
QK_ROPE = 32
V_HEAD = 64
QK_HEAD = QK_NOPE + QK_ROPE
MLA_W = MLA_HEADS * V_HEAD
CONV_W = 256
CONV_GROUPS = 4
RET_HEADS = 4
RET_DK = 64
RET_DV = 64
RET_W = RET_HEADS * RET_DV
RET_CHUNK = 128
MIX_W = MLA_W + CONV_W + RET_W
IN_COLS = Q_LORA + KV_LORA + QK_ROPE + 3 * CONV_W + 2 * RET_HEADS * RET_DK + 2 * RET_W
FFN_HIDDEN = ((8 * D_MODEL // 3 + 255) // 256) * 256
Q_BLOCK = 128
ROPE_THETA = 10000.0
EPS = 1e-6

kernel_name = "hybrid_mla_conv_retention_dit_step"


def _rmsnorm(x, g=None):
    x32 = x.astype(jnp.float32)
    y = (x32 * lax.rsqrt(jnp.mean(x32 * x32, axis=-1, keepdims=True) + EPS)).astype(x.dtype)
    return y if g is None else y * g


def _modulation(cond, ada_w, ada_b):
    m = jax.nn.silu(cond) @ ada_w + ada_b
    return [p[:, None, :] for p in jnp.split(m, 6, axis=-1)]


def _modulate(h, shift, scale):
    return h * (1.0 + scale) + shift


def _rope_2d(x):
    n = x.shape[1]
    rows = n // GRID_W
    row = jnp.repeat(jnp.arange(rows), GRID_W).astype(jnp.float32)
    col = jnp.tile(jnp.arange(GRID_W), rows).astype(jnp.float32)
    half = QK_ROPE // 2
    freqs = jnp.power(ROPE_THETA, -jnp.arange(0, half, 2, dtype=jnp.float32) / half)

    def rot(xa, pos):
        ang = pos[:, None] * freqs[None, :]
        cos = jnp.cos(ang)[None, :, None, :]
        sin = jnp.sin(ang)[None, :, None, :]
        x1, x2 = jnp.split(xa.astype(jnp.float32), 2, axis=-1)
        return jnp.concatenate([x1 * cos - x2 * sin, x1 * sin + x2 * cos], axis=-1)

    xr, xc = jnp.split(x, 2, axis=-1)
    return jnp.concatenate([rot(xr, row), rot(xc, col)], axis=-1).astype(x.dtype)


def _attention(q, k, v):
    b, h, tq, dq = q.shape
    nblk = tq // Q_BLOCK
    qb = jnp.moveaxis(q.reshape(b, h, nblk, Q_BLOCK, dq), 2, 0)
    scale = QK_HEAD ** -0.5

    def block(qi):
        s = jnp.einsum("bhqd,bhkd->bhqk", qi, k).astype(jnp.float32) * scale
        p = jax.nn.softmax(s, axis=-1).astype(v.dtype)
        return jnp.einsum("bhqk,bhkd->bhqd", p, v)

    o = lax.map(block, qb)
    return jnp.moveaxis(o, 0, 2).reshape(b, h, tq, V_HEAD)


def _mla_kv(c_kv, k_pe, w_kv_up, k_head_g):
    b, t, _ = c_kv.shape
    kv = (c_kv @ w_kv_up).reshape(b, t, MLA_HEADS, QK_NOPE + V_HEAD)
    k_nope, v = jnp.split(kv, [QK_NOPE], axis=-1)
    k = jnp.concatenate([k_nope, jnp.broadcast_to(k_pe[:, :, None, :], (b, t, MLA_HEADS, QK_ROPE))], axis=-1)
    return _rmsnorm(k, k_head_g), v


def _short_conv(gb, gc, xin, conv_w):
    u = gc * xin
    up = jnp.pad(u, ((0, 0), (1, 1), (0, 0)))
    y = up[:, :-2] * conv_w[0] + up[:, 1:-1] * conv_w[1] + up[:, 2:] * conv_w[2]
    return gb * y


def _retention_scan(q, k, v, log_gamma, s0):
    b, t, hh, _ = q.shape
    n = t // RET_CHUNK

    def chunks(a):
        a = a.astype(jnp.float32).reshape(b, n, RET_CHUNK, hh, a.shape[-1])
        return jnp.moveaxis(a, 1, 0).transpose(0, 1, 3, 2, 4)

    idx = jnp.arange(RET_CHUNK, dtype=jnp.float32)
    lg = log_gamma[:, None]
    diff = idx[:, None] - idx[None, :]
    decay = jnp.exp(jnp.where(diff >= 0, lg[:, :, None] * diff, -jnp.inf))
    q_dec = jnp.exp(lg * (idx + 1.0))[:, :, None]
    k_dec = jnp.exp(lg * (RET_CHUNK - 1.0 - idx))[:, :, None]
    c_dec = jnp.exp(lg * RET_CHUNK)[:, :, None]

    def step(s, inp):
        qi, ki, vi = inp
        scores = jnp.einsum("bhqd,bhkd->bhqk", qi, ki) * decay
        o = jnp.einsum("bhqk,bhkv->bhqv", scores, vi) + jnp.einsum("bhqd,bhdv->bhqv", qi * q_dec, s)
        s = s * c_dec + jnp.einsum("bhkd,bhkv->bhdv", ki * k_dec, vi)
        return s, o

    s_fin, o = lax.scan(step, s0.astype(jnp.float32), (chunks(q), chunks(k), chunks(v)))
    o = jnp.moveaxis(o.transpose(0, 1, 3, 2, 4), 0, 1).reshape(b, t, hh, RET_DV)
    return o, s_fin


def _retention(rq, rk, rv, rg, lg_f, lg_b, s0_f, s0_b):
    b, t, _ = rq.shape
    q = rq.reshape(b, t, RET_HEADS, RET_DK)
    k = rk.reshape(b, t, RET_HEADS, RET_DK) * (RET_DK ** -0.5)
    v = rv.reshape(b, t, RET_HEADS, RET_DV)
    o_f, s_f = _retention_scan(q, k, v, lg_f, s0_f)
    o_b, s_b = _retention_scan(q[:, ::-1], k[:, ::-1], v[:, ::-1], lg_b, s0_b)
    o = _rmsnorm(o_f + o_b[:, ::-1])
    return o.reshape(b, t, RET_W).astype(rg.dtype) * jax.nn.silu(rg), s_f, s_b


def _token_mixer(h, w_in, q_norm_g, kv_norm_g, w_q_up, w_kv_up, q_head_g, k_head_g,
                 conv_w, lg_f, lg_b, w_o, ctx_ckv=None, ctx_kpe=None, s0_f=None, s0_b=None):
    latent = ctx_ckv is not None
    b, t, _ = h.shape
    widths = [Q_LORA, KV_LORA, QK_ROPE, CONV_W, CONV_W, CONV_W,
              RET_HEADS * RET_DK, RET_HEADS * RET_DK, RET_W]
    splits = [int(s) for s in np.cumsum(widths)]
    q_lat, kv_lat, k_pe, gb, gc, xin, rq, rk, rv, rg = jnp.split(h @ w_in, splits, axis=-1)

    c_kv = _rmsnorm(kv_lat, kv_norm_g)
    q = (_rmsnorm(q_lat, q_norm_g) @ w_q_up).reshape(b, t, MLA_HEADS, QK_HEAD)
    q = _rmsnorm(q, q_head_g)
    k, v = _mla_kv(c_kv, k_pe, w_kv_up, k_head_g)
    if latent:
        q = jnp.concatenate([q[..., :QK_NOPE], _rope_2d(q[..., QK_NOPE:])], axis=-1)
        k = jnp.concatenate([k[..., :QK_NOPE], _rope_2d(k[..., QK_NOPE:])], axis=-1)
        k_c, v_c = _mla_kv(ctx_ckv, ctx_kpe, w_kv_up, k_head_g)
        k = jnp.concatenate([k, k_c], axis=1)
        v = jnp.concatenate([v, v_c], axis=1)
    else:
        s0_f = jnp.zeros((b, RET_HEADS, RET_DK, RET_DV), jnp.float32)
        s0_b = s0_f
    attn = _attention(q.transpose(0, 2, 1, 3), k.transpose(0, 2, 1, 3), v.transpose(0, 2, 1, 3))
    attn = attn.transpose(0, 2, 1, 3).reshape(b, t, MLA_W)

    conv = _short_conv(gb, gc, xin, conv_w)

    ret, s_f, s_b = _retention(rq, rk, rv, rg, lg_f, lg_b, s0_f, s0_b)

    out = jnp.concatenate([attn, conv, ret], axis=-1) @ w_o
    return out, c_kv, k_pe, s_f, s_b


def _swiglu(h, w_gate, w_up, w_down):
    return (jax.nn.silu(h @ w_gate) * (h @ w_up)) @ w_down


def setup_inputs(seed: int = 0) -> dict:
    key = jax.random.key(seed)
    ks = jax.random.split(key, 25)
    f32 = jnp.float32

    def nrm(k, shape, scale=1.0):
        return jax.random.normal(k, shape, f32) * scale

    def gain(k, shape):
        return 1.0 + 0.05 * jax.random.normal(k, shape, f32)

    p = 1.0 - jnp.power(2.0, -5.0 - jnp.arange(RET_HEADS, dtype=f32))
    decay_logit = jnp.log(p) - jnp.log1p(-p)
    return {
        "x_prompt": nrm(ks[0], (BATCH, SEQ, D_MODEL)),
        "x_sample": nrm(ks[1], (DEC_BATCH, DEC_SEQ, D_MODEL)),
        "cache_ckv": nrm(ks[2], (DEC_BATCH, DEPTH, PAST_LEN, KV_LORA)),
        "cache_kpe": nrm(ks[3], (DEC_BATCH, DEPTH, PAST_LEN, QK_ROPE)),
        "state_ret": nrm(ks[4], (DEC_BATCH, DEPTH, 2, RET_HEADS, RET_DK, RET_DV), 0.1),
        "c": nrm(ks[5], (DEC_BATCH, D_MODEL)),
        "c_ctx": nrm(ks[6], (D_MODEL,)),
        "ada_w": nrm(ks[7], (DEPTH, D_MODEL, 6 * D_MODEL), 0.3 * D_MODEL ** -0.5),
        "ada_b": nrm(ks[8], (DEPTH, 6 * D_MODEL), 0.01),
        "norm1_g": gain(ks[9], (DEPTH, D_MODEL)),
        "norm2_g": gain(ks[10], (DEPTH, D_MODEL)),
        "w_in": nrm(ks[11], (DEPTH, D_MODEL, IN_COLS), D_MODEL ** -0.5),
        "q_norm_g": gain(ks[12], (DEPTH, Q_LORA)),
        "kv_norm_g": gain(ks[13], (DEPTH, KV_LORA)),
        "w_q_up": nrm(ks[14], (DEPTH, Q_LORA, MLA_HEADS * QK_HEAD), Q_LORA ** -0.5),
        "w_kv_up": nrm(ks[15], (DEPTH, KV_LORA, MLA_HEADS * (QK_NOPE + V_HEAD)), KV_LORA ** -0.5),
        "q_head_norm_g": gain(ks[16], (DEPTH, QK_HEAD)),
        "k_head_norm_g": gain(ks[17], (DEPTH, QK_HEAD)),
        "conv_w": nrm(ks[18], (DEPTH, 3, CONV_W), 3 ** -0.5),
        "ret_decay_fwd": decay_logit[None, :] + nrm(ks[19], (DEPTH, RET_HEADS), 0.1),
        "ret_decay_bwd": decay_logit[None, :] + nrm(ks[20], (DEPTH, RET_HEADS), 0.1),
        "w_o": nrm(ks[21], (DEPTH, MIX_W, D_MODEL), MIX_W ** -0.5),
        "w_ffn_gate": nrm(ks[22], (DEPTH, D_MODEL, FFN_HIDDEN), D_MODEL ** -0.5),
        "w_ffn_up": nrm(ks[23], (DEPTH, D_MODEL, FFN_HIDDEN), D_MODEL ** -0.5),
        "w_ffn_down": nrm(ks[24], (DEPTH, FFN_HIDDEN, D_MODEL), FFN_HIDDEN ** -0.5),
    }


def reference(x_prompt, x_sample, cache_ckv, cache_kpe, state_ret, c, c_ctx,
              ada_w, ada_b, norm1_g, norm2_g, w_in, q_norm_g, kv_norm_g, w_q_up, w_kv_up,
              q_head_norm_g, k_head_norm_g, conv_w, ret_decay_fwd, ret_decay_bwd, w_o,
              w_ffn_gate, w_ffn_up, w_ffn_down):
    xp, xs = x_prompt, x_sample
    ckv_list, kpe_list, st_list = [], [], []
    for l in range(DEPTH):
        lw = (w_in[l], q_norm_g[l], kv_norm_g[l], w_q_up[l], w_kv_up[l],
              q_head_norm_g[l], k_head_norm_g[l], conv_w[l],
              jax.nn.log_sigmoid(ret_decay_fwd[l].astype(jnp.float32)),
              jax.nn.log_sigmoid(ret_decay_bwd[l].astype(jnp.float32)), w_o[l])
        ffn = (w_ffn_gate[l], w_ffn_up[l], w_ffn_down[l])

        sh1, sc1, g1, sh2, sc2, g2 = _modulation(c_ctx[None, :], ada_w[l], ada_b[l])
        mix, ckv, kpe, s_f, s_b = _token_mixer(_modulate(_rmsnorm(xp, norm1_g[l]), sh1, sc1), *lw)
        xp = xp + g1 * mix
        xp = xp + g2 * _swiglu(_modulate(_rmsnorm(xp, norm2_g[l]), sh2, sc2), *ffn)
        ckv_list.append(ckv)
        kpe_list.append(kpe)
        st_list.append(jnp.stack([s_f, s_b], axis=1).astype(xp.dtype))

        sh1, sc1, g1, sh2, sc2, g2 = _modulation(c, ada_w[l], ada_b[l])
        mix, _, _, _, _ = _token_mixer(_modulate(_rmsnorm(xs, norm1_g[l]), sh1, sc1), *lw,
                                       cache_ckv[:, l], cache_kpe[:, l],
                                       state_ret[:, l, 0], state_ret[:, l, 1])
        xs = xs + g1 * mix
        xs = xs + g2 * _swiglu(_modulate(_rmsnorm(xs, norm2_g[l]), sh2, sc2), *ffn)

    new_ckv = jnp.stack(ckv_list, axis=1)
    new_kpe = jnp.stack(kpe_list, axis=1)
    new_state_ret = jnp.stack(st_list, axis=1)
    return (xp, xs, new_ckv, new_kpe, new_state_ret)
```

```cpp
#include <hip/hip_runtime.h>
#include <hip/hip_cooperative_groups.h>
#include <stdint.h>
#include <cstdio>
namespace cg = cooperative_groups;

#ifndef MK_MULTI
#define MK_MULTI 0
#endif

typedef unsigned short bf16_t;
typedef short bf16x8 __attribute__((ext_vector_type(8)));
typedef float f32x4 __attribute__((ext_vector_type(4)));
typedef float f32x16 __attribute__((ext_vector_type(16)));
typedef unsigned u32x4 __attribute__((ext_vector_type(4)));
typedef u32x4 __attribute__((may_alias)) u32x4_ma;

constexpr int NTOK = 16384;
constexpr int NKV = 17408;
constexpr int INC = 2208;
constexpr int FFH = 2816;
constexpr float EPS = 1e-6f;

constexpr size_t OUT_CKV = 16777216, OUT_KPE = 18874368, OUT_ST = 19398656;

constexpr size_t WS_BAR = 0;
constexpr size_t WS_MOD = 16384;
constexpr size_t WS_MSQ = WS_MOD + 2 * 5 * 6144 * 4;
constexpr size_t WS_WIN = WS_MSQ + NTOK * 4;
constexpr size_t WS_WQUP = WS_WIN + (size_t)2304 * 1024 * 2;
constexpr size_t WS_WKV = WS_WQUP + (size_t)768 * 256 * 2;
constexpr size_t WS_WO = WS_WKV + (size_t)1024 * 128 * 2;
constexpr size_t WS_WGU = WS_WO + (size_t)1024 * 1024 * 2;
constexpr size_t WS_WDN = WS_WGU + (size_t)5632 * 1024 * 2;
constexpr size_t WS_HM = WS_WDN + (size_t)1024 * 2816 * 2;
constexpr size_t WS_PROJ = WS_HM + (size_t)NTOK * 1024 * 2;
constexpr size_t WS_CKV = WS_PROJ + (size_t)NTOK * INC * 2;
constexpr size_t WS_QRAW = WS_CKV + (size_t)NKV * 128 * 2;
constexpr size_t WS_KRAW = WS_QRAW + (size_t)NTOK * 768 * 2;
constexpr size_t WS_KB = WS_KRAW + (size_t)NKV * 512 * 2;
constexpr size_t WS_VT = WS_KB + (size_t)NKV * 768 * 2;
constexpr size_t WS_U = WS_VT + (size_t)512 * NKV * 2;
constexpr size_t WS_END = WS_U + (size_t)128 * 4 * 2 * 4096 * 4;
constexpr size_t WS_ACT = WS_PROJ;
static_assert((size_t)NTOK * FFH * 2 <= WS_KRAW - WS_PROJ, "ACT overlay");
static_assert(WS_END <= (size_t)256 * 1024 * 1024, "workspace");

constexpr int VSMEM = 67584;
constexpr int SMEM_BYTES = 2 * VSMEM;

struct Params {
    const float* in[25];
    float* out;
    unsigned char* ws;
};
typedef const Params __attribute__((address_space(4)))* PP;

__device__ __forceinline__ float bflo(unsigned u) { return __uint_as_float(u << 16); }
__device__ __forceinline__ float bfhi(unsigned u) { return __uint_as_float(u & 0xffff0000u); }
__device__ __forceinline__ float bf2f(bf16_t b) { return __uint_as_float(((unsigned)b) << 16); }
__device__ __forceinline__ unsigned pack2(float lo, float hi) { unsigned r; asm("v_cvt_pk_bf16_f32 %0, %1, %2" : "=v"(r) : "v"(lo), "v"(hi)); return r; }
__device__ __forceinline__ bf16x8 mk8(unsigned a, unsigned b, unsigned c, unsigned d) { u32x4 v = {a, b, c, d}; return __builtin_bit_cast(bf16x8, v); }
__device__ __forceinline__ float wave_sum(float v) {
#pragma unroll
    for (int o = 32; o; o >>= 1) v += __shfl_xor(v, o);
    return v;
}
__device__ __forceinline__ float fexp2(float x) { return __builtin_amdgcn_exp2f(x); }
__device__ __forceinline__ int opaque_bid() { int b = blockIdx.x; asm volatile("" : "+s"(b)); return b; }
__device__ __forceinline__ int opaque_tid() { int t = threadIdx.x; asm volatile("" : "+v"(t)); return t & 255; }
__device__ __forceinline__ int opaque_tid_full() { int t = threadIdx.x; asm volatile("" : "+v"(t)); return t; }

#define XB_TMO      128
#define XB_XCNT(j)  (256  + 64 * (j))
#define XB_XSUB(j)  (1280 + 64 * (j))
#define XB_XGEN(j)  (2304 + 64 * (j))
#define XB_TOP      3328
#define XB_TOPGEN   3392
#define XCD_BAR_WORDS 3456
#define XB_SPIN_CAP (1u << 22)
#define LAS __attribute__((address_space(3)))
__device__ __forceinline__ unsigned xb_ld(unsigned* p)              { return __hip_atomic_load(p, __ATOMIC_RELAXED, __HIP_MEMORY_SCOPE_AGENT); }
__device__ __forceinline__ unsigned xb_add(unsigned* p, unsigned v) { return __hip_atomic_fetch_add(p, v, __ATOMIC_RELAXED, __HIP_MEMORY_SCOPE_AGENT); }
__device__ __forceinline__ unsigned xb_xcc_id() { return (unsigned)__builtin_amdgcn_s_getreg((3 << 11) | 20) & 0xFu; }
#define XB_SPIN(cond, bar) do { unsigned _sp = 0; while (cond) { __builtin_amdgcn_s_sleep(1); \
    if ((++_sp & 255u) == 0u) { if (xb_ld(&(bar)[XB_TMO])) break; if (_sp > XB_SPIN_CAP) { atomicAdd(&(bar)[XB_TMO], 1u); break; } } } } while (0)
struct XcdBarrier { unsigned* bar; unsigned x; volatile LAS unsigned* st; };
__device__ __forceinline__ XcdBarrier xcd_barrier_post(unsigned* bar, volatile LAS unsigned* st) {
    XcdBarrier b; b.bar = bar; b.x = xb_xcc_id(); b.st = st;
    if (opaque_tid_full() == 0) (void)xb_add(&bar[XB_XCNT(b.x)], 1u);
    return b;
}
__device__ __forceinline__ void xcd_barrier_complete(unsigned* bar, unsigned x, unsigned& nloc, unsigned& nx) {
    const unsigned G = gridDim.x * gridDim.y * gridDim.z;
    unsigned sum, cnt, mine, sp = 0u;
    for (;;) {
        sum = 0u; cnt = 0u; mine = 0u;
#pragma unroll
        for (unsigned j = 0; j < 16; ++j) { const unsigned c = xb_ld(&bar[XB_XCNT(j)]); sum += c; cnt += (c > 0u) ? 1u : 0u; mine = (j == x) ? c : mine; }
        if (sum == G) break;
        __builtin_amdgcn_s_sleep(1);
        if ((++sp & 255u) == 0u) { if (xb_ld(&bar[XB_TMO])) break; if (sp > XB_SPIN_CAP) { atomicAdd(&bar[XB_TMO], 1u); break; } }
    }
    nloc = mine > 0u ? mine : 1u; nx = cnt > 0u ? cnt : 1u;
}
__device__ __forceinline__ void xcd_barrier(const XcdBarrier& b) {
    asm volatile("s_waitcnt vmcnt(0)" ::: "memory");
    __syncthreads();
    if (opaque_tid_full() == 0) {
        unsigned* bar = b.bar;
        __builtin_amdgcn_s_waitcnt(0);
        unsigned nloc = b.st[0], nx = b.st[1];
        if (nloc == 0u) { xcd_barrier_complete(bar, b.x, nloc, nx); b.st[0] = nloc; b.st[1] = nx; }
        const unsigned old = xb_add(&bar[XB_XSUB(b.x)], 1u);
        const unsigned gen = old / nloc;
        if (old + 1u == (gen + 1u) * nloc) {
            __builtin_amdgcn_fence(__ATOMIC_RELEASE, "agent");
            asm volatile("s_waitcnt vmcnt(0)" ::: "memory");
            const unsigned og = xb_add(&bar[XB_TOP], 1u);
            const unsigned tg = og / nx;
            if (og + 1u == (tg + 1u) * nx) xb_add(&bar[XB_TOPGEN], 1u);
            else XB_SPIN(xb_ld(&bar[XB_TOPGEN]) == tg, bar);
            __builtin_amdgcn_fence(__ATOMIC_ACQUIRE, "agent");
            xb_add(&bar[XB_XGEN(b.x)], 1u);
            asm volatile("s_waitcnt vmcnt(0)" ::: "memory");
        } else {
            XB_SPIN(xb_ld(&bar[XB_XGEN(b.x)]) == gen, bar);
            __builtin_amdgcn_fence(__ATOMIC_ACQUIRE, "agent");
            asm volatile("s_waitcnt vmcnt(0)" ::: "memory");
        }
    }
    __syncthreads();
}

__device__ __forceinline__ void rope_cs(int pos, int fi, float& cs, float& sn) {
    const float freq = exp2f(-(float)fi * 1.6609640474436813f);
    const float ang = (float)pos * freq;
    const float rev = ang * 0.15915494309189535f;
    sn = __builtin_amdgcn_sinf(rev); cs = __builtin_amdgcn_cosf(rev);
}

enum { EPI_BF16 = 0, EPI_VT = 1, EPI_RESID = 2, EPI_SWIGLU = 3, EPI_KHEAD = 4 };
struct Epi {
    bf16_t* obf; int ldc; int ncols;
    float* X; const float* xs0; const float* xs1; const float* gate;
    const bf16_t* proj; const float* ckpe; int lyr;
};

__device__ __forceinline__ int swz(int r, int chunk) {
    const int line = r >> 1; int slot = ((r & 1) << 3) | chunk; slot ^= (line & 15);
    return line * 256 + slot * 16;
}

__device__ __forceinline__ bool tile_at(int nM, int nN, int i, int& tm, int& tn) {
    const int xcd = opaque_bid() & 7;
    const int mx = (nM - xcd + 7) >> 3;
    if (i >= mx * nN) return false;
    const int per = mx * 4, nfull = nN >> 2;
    const int c = i / per;
    if (c < nfull) { const int r = i - c * per; tm = xcd + 8 * (r >> 2); tn = c * 4 + (r & 3); }
    else { const int rem = i - nfull * per; const int tw = nN & 3; tm = xcd + 8 * (rem / tw); tn = nfull * 4 + rem % tw; }
    return true;
}


template <int EPI, bool EARLYW = true, int NI = 4, int MI = 8>
__device__ __forceinline__ void gemm_phase(const bf16_t* __restrict__ A, int lda, const bf16_t* __restrict__ B, int ldb, int M, int N, int K,
                                           const Epi& ep, unsigned char* smem, int mode = 0, int rot = 0) {
    const int t = opaque_tid_full(), lane = t & 63, w = t >> 6;
    const int wr = w >> 2, wc = w & 3;
    const int l15 = lane & 15, lq = lane >> 4;
    const int lrow = t >> 3, lch = t & 7;
    constexpr int NT = 64 * NI, WN = 16 * NI, WM = 16 * MI;
    const int nM = M >> 8, nN = N / NT, nk = K >> 6;
    int istep = gridDim.x >> 3;
    int li = ((opaque_bid() >> 3) + rot) % istep, ltm = 0, ltn = 0, lkt = 0, lim, hrow = 0;
    {
        const int xcd = opaque_bid() & 7;
        const int total = ((nM - xcd + 7) >> 3) * nN;
        const int full = (total / istep) * istep;
        if (mode == 2) {
            if (li >= 2 * (total - full)) return;
            hrow = (li & 1) * 128; li = full + (li >> 1); lim = li + 1; istep = 1;
        } else lim = mode == 1 ? full : total;
    }
    if (li >= lim || !tile_at(nM, nN, li, ltm, ltn)) return;
    const int T = ((lim - li + istep - 1) / istep) * nk;
    int ci = li, ctm = ltm, ctn = ltn, ckt = 0;
    u32x4 xa0, xa1, xa2, xa3, xb0, xb1, xb2, xb3;
    f32x4 acc[MI][NI];
    { float z = 0.f; asm volatile("" : "+v"(z));
#pragma unroll
      for (int i = 0; i < MI; ++i)
#pragma unroll
        for (int j = 0; j < NI; ++j) acc[i][j] = (f32x4){z, z, z, z}; }

    const size_t ars = (size_t)lda * 128, brs = (size_t)ldb * 128;
#define G_LOAD() { \
        const int tl_ = opaque_tid_full(); \
        const unsigned ag0 = (unsigned)((tl_ >> 3) * lda + (tl_ & 7) * 8) * 2u, bg0 = (unsigned)((tl_ >> 3) * ldb + (tl_ & 7) * 8) * 2u; \
        const unsigned char* ga_ = (const unsigned char*)(A + (size_t)(ltm * 256 + hrow) * lda + lkt * 64); \
        const unsigned char* gb_ = (const unsigned char*)(B + (size_t)(ltn * NT) * ldb + lkt * 64); \
        xa0 = *(const u32x4_ma*)(ga_ + ag0); xa1 = *(const u32x4_ma*)(ga_ + ars + ag0); if (MI == 8) { xa2 = *(const u32x4_ma*)(ga_ + 2 * ars + ag0); xa3 = *(const u32x4_ma*)(ga_ + 3 * ars + ag0); } \
        xb0 = *(const u32x4_ma*)(gb_ + bg0); xb1 = *(const u32x4_ma*)(gb_ + brs + bg0); xb2 = *(const u32x4_ma*)(gb_ + 2 * brs + bg0); if (NI == 4) xb3 = *(const u32x4_ma*)(gb_ + 3 * brs + bg0); \
        if (++lkt == nk) { lkt = 0; li += istep; if (li < lim) tile_at(nM, nN, li, ltm, ltn); } }
#define G_WRITE(BUF) { \
        const int tw_ = opaque_tid_full(); \
        unsigned char* d_ = smem + (BUF) * 65536 + swz(tw_ >> 3, tw_ & 7); \
        *(u32x4_ma*)(d_) = xa0; *(u32x4_ma*)(d_ + 8192) = xa1; if (MI == 8) { *(u32x4_ma*)(d_ + 16384) = xa2; *(u32x4_ma*)(d_ + 24576) = xa3; } \
        *(u32x4_ma*)(d_ + 32768) = xb0; *(u32x4_ma*)(d_ + 40960) = xb1; *(u32x4_ma*)(d_ + 49152) = xb2; if (NI == 4) *(u32x4_ma*)(d_ + 57344) = xb3; }
#define G_AF(MIX) __builtin_bit_cast(bf16x8, *(const u32x4_ma*)(s_ + (((MIX) & 1) ? fa1_ : fa0_) + ((MIX) >> 1) * 4096))
#define G_MM(MIX, AFR) { _Pragma("unroll") for (int ni = 0; ni < NI; ++ni) { \
            if (EPI == EPI_VT) acc[(MIX) < MI ? (MIX) : 0][ni] = __builtin_amdgcn_mfma_f32_16x16x32_bf16(AFR, bfr[ni], acc[(MIX) < MI ? (MIX) : 0][ni], 0, 0, 0); \
            else acc[(MIX) < MI ? (MIX) : 0][ni] = __builtin_amdgcn_mfma_f32_16x16x32_bf16(bfr[ni], AFR, acc[(MIX) < MI ? (MIX) : 0][ni], 0, 0, 0); } }
#define G_PIECE(BUF, WOK, XP, XQ, GBASE, RS, GOFF, LOFF, I0) { \
        const int tp_ = opaque_tid_full(); \
        if (WOK) { unsigned char* d_ = smem + ((BUF) ^ 1) * 65536 + (LOFF) + swz(tp_ >> 3, tp_ & 7); \
            *(u32x4_ma*)(d_ + (I0) * 8192) = XP; *(u32x4_ma*)(d_ + ((I0) + 1) * 8192) = XQ; } \
        const unsigned go_ = (unsigned)((tp_ >> 3) * (GOFF) + (tp_ & 7) * 8) * 2u; \
        XP = *(const u32x4_ma*)((GBASE) + (size_t)(I0) * (RS) + go_); XQ = *(const u32x4_ma*)((GBASE) + (size_t)((I0) + 1) * (RS) + go_); }
#define G_PIECE1(BUF, WOK, XP, GBASE, RS, GOFF, LOFF, I0) { \
        const int tp_ = opaque_tid_full(); \
        if (WOK) { unsigned char* d_ = smem + ((BUF) ^ 1) * 65536 + (LOFF) + swz(tp_ >> 3, tp_ & 7); *(u32x4_ma*)(d_ + (I0) * 8192) = XP; } \
        const unsigned go_ = (unsigned)((tp_ >> 3) * (GOFF) + (tp_ & 7) * 8) * 2u; \
        XP = *(const u32x4_ma*)((GBASE) + (size_t)(I0) * (RS) + go_); }
#define G_KS(BUF, KX, HOOK1, HOOK2) { \
        const unsigned char* s_ = smem + (BUF) * 65536; \
        const int tk_ = opaque_tid_full(), lk_ = tk_ & 15, qk_ = (tk_ >> 4) & 3, ra_ = (tk_ >> 8) * WM + lk_, rb_ = ((tk_ >> 6) & 3) * WN + lk_; \
        const unsigned fa0_ = swz(ra_, qk_) ^ (KX), fa1_ = swz(ra_ + 16, qk_) ^ (KX), fb0_ = (32768u + swz(rb_, qk_)) ^ (KX), fb1_ = (32768u + swz(rb_ + 16, qk_)) ^ (KX); \
        bf16x8 bfr[NI]; \
        if (NI == 4) { _Pragma("unroll") for (int j = 0; j < 2; ++j) { \
            bfr[2 * j] = __builtin_bit_cast(bf16x8, *(const u32x4_ma*)(s_ + fb0_ + j * 4096)); \
            bfr[2 * j + 1] = __builtin_bit_cast(bf16x8, *(const u32x4_ma*)(s_ + fb1_ + j * 4096)); } } \
        else { _Pragma("unroll") for (int j = 0; j < NI; ++j) bfr[j] = __builtin_bit_cast(bf16x8, *(const u32x4_ma*)(s_ + ((32768u + swz(rb_ + 16 * j, qk_)) ^ (KX)))); } \
        bf16x8 afA = G_AF(0), afB = G_AF(1), afC = G_AF(2); \
        if (MI == 8) { \
            G_MM(0, afA); afA = G_AF(3); \
            G_MM(1, afB); afB = G_AF(4); __builtin_amdgcn_sched_barrier(0); \
            HOOK1; \
            G_MM(2, afC); afC = G_AF(5); \
            G_MM(3, afA); afA = G_AF(6); \
            G_MM(4, afB); afB = G_AF(7); \
            G_MM(5, afC); __builtin_amdgcn_sched_barrier(0); \
            HOOK2; \
            G_MM(6, afA); \
            G_MM(7, afB); \
        } else { \
            G_MM(0, afA); afA = G_AF(3); \
            G_MM(1, afB); __builtin_amdgcn_sched_barrier(0); \
            HOOK1; \
            G_MM(2, afC); __builtin_amdgcn_sched_barrier(0); \
            HOOK2; \
            G_MM(3, afA); } }
#define G_COMPUTE(BUF) { G_KS(BUF, 0u, ;, ;); G_KS(BUF, 64u, ;, ;); }
#define G_STEP(BUF, SIDX) { \
        if (EARLYW) { \
            const bool wok_ = (SIDX) + 1 < T; \
            const unsigned char* ga_ = (const unsigned char*)(A + (size_t)(ltm * 256 + hrow) * lda + lkt * 64); \
            const unsigned char* gb_ = (const unsigned char*)(B + (size_t)(ltn * NT) * ldb + lkt * 64); \
            G_KS(BUF, 0u, G_PIECE(BUF, wok_, xa0, xa1, ga_, ars, lda, 0, 0), if (MI == 8) G_PIECE(BUF, wok_, xa2, xa3, ga_, ars, lda, 0, 2)); \
            G_KS(BUF, 64u, G_PIECE(BUF, wok_, xb0, xb1, gb_, brs, ldb, 32768, 0), if (NI == 4) G_PIECE(BUF, wok_, xb2, xb3, gb_, brs, ldb, 32768, 2) else G_PIECE1(BUF, wok_, xb2, gb_, brs, ldb, 32768, 2)); \
            if (++lkt == nk) { lkt = 0; li += istep; if (li < lim) tile_at(nM, nN, li, ltm, ltn); } } \
        else { G_LOAD(); G_COMPUTE(BUF); if ((SIDX) + 1 < T) G_WRITE((BUF) ^ 1); } }

    G_LOAD();
    G_WRITE(0);
    if (EARLYW) G_LOAD();
    __syncthreads();
    for (int s = 0; s < T; s += 2) {
        G_STEP(0, s);
        __syncthreads();
        G_STEP(1, s + 1);
        ckt += 2;
        if (ckt == nk) {
            { const int m0 = ctm * 256 + hrow, n0 = ctn * NT;
              const int te = opaque_tid_full(), le = te & 63, l15 = le & 15, lq = le >> 4, wr = te >> 8, wc = (te >> 6) & 3;
    if (EPI == EPI_VT) {
#pragma unroll
        for (int mi = 0; mi < MI; ++mi)
#pragma unroll
            for (int ni = 0; ni < NI; ++ni) {
                const int m = m0 + wr * WM + mi * 16 + lq * 4, n = n0 + wc * WN + ni * 16 + l15;
                uint2 v; v.x = pack2(acc[mi][ni][0], acc[mi][ni][1]); v.y = pack2(acc[mi][ni][2], acc[mi][ni][3]);
                *(uint2*)(ep.obf + (size_t)n * ep.ldc + m) = v;
            }
    } else if (EPI == EPI_BF16) {
#pragma unroll
        for (int mi = 0; mi < MI; ++mi)
#pragma unroll
            for (int ni = 0; ni < NI; ++ni) {
                const int row = m0 + wr * WM + mi * 16 + l15, col = n0 + wc * WN + ni * 16 + lq * 4;
                if (col < ep.ncols) {
                    uint2 v; v.x = pack2(acc[mi][ni][0], acc[mi][ni][1]); v.y = pack2(acc[mi][ni][2], acc[mi][ni][3]);
                    *(uint2*)(ep.obf + (size_t)row * ep.ldc + col) = v;
                }
            }
    } else if (EPI == EPI_RESID) {
#pragma unroll
        for (int mi = 0; mi < MI; ++mi) {
            const int row = m0 + wr * WM + mi * 16 + l15;
            const float* src = row < 8192 ? ep.xs0 + (size_t)row * 1024 : ep.xs1 + (size_t)(row - 8192) * 1024;
            const int cond = row < 8192 ? 0 : 1 + ((row - 8192) >> 11);
            const float* g = ep.gate + cond * 6144;
            float* dst = ep.X + (size_t)row * 1024;
#pragma unroll
            for (int ni = 0; ni < NI; ++ni) {
                const int col = n0 + wc * WN + ni * 16 + lq * 4;
                const f32x4 xv = *(const f32x4*)(src + col);
                const f32x4 gv = *(const f32x4*)(g + col);
                f32x4 o = xv + gv * acc[mi][ni];
                *(f32x4*)(dst + col) = o;
            }
        }
    } else if (EPI == EPI_KHEAD) {
        const int h = (n0 >> 6) + wc;
        const float* kg = ep.gate;
        int ttype, tb = 0, tt0 = 0;
        if (m0 < 8192) ttype = 0;
        else { const int r2 = m0 - 8192; tb = r2 / 2304; tt0 = r2 - tb * 2304; ttype = tt0 < 2048 ? 1 : 2; }
#pragma unroll
        for (int mi = 0; mi < MI; ++mi) {
            const int rl = wr * WM + mi * 16 + l15;
            const int row = m0 + rl;
            float kp[8];
            if (ttype == 2) {
                const float* cs_ = ep.ckpe + ((size_t)((tb * 2 + ep.lyr) * 256 + (tt0 - 2048 + rl))) * 32 + lq * 8;
                const float4 c0 = *(const float4*)cs_, c1 = *(const float4*)(cs_ + 4);
                kp[0] = c0.x; kp[1] = c0.y; kp[2] = c0.z; kp[3] = c0.w; kp[4] = c1.x; kp[5] = c1.y; kp[6] = c1.z; kp[7] = c1.w;
            } else {
                const int msrc = ttype == 0 ? row : 8192 + tb * 2048 + tt0 + rl;
                const uint4 u = *(const uint4*)(ep.proj + (size_t)msrc * INC + 384 + lq * 8);
                kp[0] = bflo(u.x); kp[1] = bfhi(u.x); kp[2] = bflo(u.y); kp[3] = bfhi(u.y); kp[4] = bflo(u.z); kp[5] = bfhi(u.z); kp[6] = bflo(u.w); kp[7] = bfhi(u.w);
            }
            float ss = 0.f;
#pragma unroll
            for (int ni = 0; ni < NI; ++ni)
#pragma unroll
                for (int r = 0; r < 4; ++r) ss += acc[mi][ni][r] * acc[mi][ni][r];
#pragma unroll
            for (int j = 0; j < 8; ++j) ss += kp[j] * kp[j];
            ss += __shfl_xor(ss, 16); ss += __shfl_xor(ss, 32);
            const float rs = rsqrtf(ss * (1.f / 96.f) + EPS);
            bf16_t* dst = ep.obf + (size_t)row * 768 + h * 96;
#pragma unroll
            for (int ni = 0; ni < NI; ++ni) {
                const float4 gv = *(const float4*)(kg + ni * 16 + lq * 4);
                uint2 v; v.x = pack2(acc[mi][ni][0] * rs * gv.x, acc[mi][ni][1] * rs * gv.y); v.y = pack2(acc[mi][ni][2] * rs * gv.z, acc[mi][ni][3] * rs * gv.w);
                *(uint2*)(dst + ni * 16 + lq * 4) = v;
            }
            const float4 g0 = *(const float4*)(kg + 64 + lq * 8), g1 = *(const float4*)(kg + 64 + lq * 8 + 4);
            kp[0] *= rs * g0.x; kp[1] *= rs * g0.y; kp[2] *= rs * g0.z; kp[3] *= rs * g0.w; kp[4] *= rs * g1.x; kp[5] *= rs * g1.y; kp[6] *= rs * g1.z; kp[7] *= rs * g1.w;
            if (ttype == 1) {
                const int tt = tt0 + rl;
                const int pos = lq < 2 ? (tt >> 6) : (tt & 63);
#pragma unroll
                for (int j = 0; j < 8; ++j) {
                    const float pv = __shfl_xor(kp[j], 16);
                    float cs, sn; rope_cs(pos, j, cs, sn);
                    kp[j] = (lq & 1) ? (kp[j] * cs + pv * sn) : (kp[j] * cs - pv * sn);
                }
            }
            uint4 o; o.x = pack2(kp[0], kp[1]); o.y = pack2(kp[2], kp[3]); o.z = pack2(kp[4], kp[5]); o.w = pack2(kp[6], kp[7]);
            *(uint4*)(dst + 64 + lq * 8) = o;
            asm volatile("" ::: "memory");
        }
    } else {
#pragma unroll
        for (int mi = 0; mi < MI; ++mi) {
            const int row = m0 + wr * WM + mi * 16 + l15;
#pragma unroll
            for (int ni = 0; ni < 2; ++ni) {
                const int col = ((n0 + wc * 64) >> 1) + ni * 16 + lq * 4;
                float a[4];
#pragma unroll
                for (int r = 0; r < 4; ++r) { const float gv = acc[mi][ni][r], uv = acc[mi][ni + 2][r]; a[r] = gv / (1.f + __expf(-gv)) * uv; }
                uint2 v; v.x = pack2(a[0], a[1]); v.y = pack2(a[2], a[3]);
                *(uint2*)(ep.obf + (size_t)row * ep.ldc + col) = v;
            }
        }
    }
            }
            { float z = 0.f; asm volatile("" : "+v"(z));
#pragma unroll
              for (int i = 0; i < MI; ++i)
#pragma unroll
                for (int j = 0; j < NI; ++j) acc[i][j] = (f32x4){z, z, z, z}; }
            ckt = 0; ci += istep; if (ci < lim) tile_at(nM, nN, ci, ctm, ctn);
            asm volatile("s_waitcnt vmcnt(0)" ::: "memory");
        }
        __syncthreads();
    }
    asm volatile("s_waitcnt vmcnt(0)" ::: "memory");
#undef G_LOAD
#undef G_WRITE
#undef G_COMPUTE
#undef G_KS
#undef G_PIECE
#undef G_PIECE1
#undef G_AF
#undef G_MM
#undef G_STEP
}

__device__ __forceinline__ void mod_item(PP p, int it, unsigned char* smem) {
    const int l = it / 192, c0 = (it % 192) * 32;
    float* ssil = (float*)smem;
    float* red = ssil + 5 * 1024;
    const int t = opaque_tid();
    for (int idx = t; idx < 5 * 1024; idx += 256) {
        const int ci = idx >> 10, k = idx & 1023;
        const float v = ci == 0 ? p->in[6][k] : p->in[5][(ci - 1) * 1024 + k];
        ssil[idx] = v / (1.f + __expf(-v));
    }
    __syncthreads();
    const int kg = t >> 5, cj = t & 31;
    const float* wp = p->in[7] + (size_t)l * 1024 * 6144 + (size_t)(kg * 128) * 6144 + c0 + cj;
    float a0 = 0.f, a1 = 0.f, a2 = 0.f, a3 = 0.f, a4 = 0.f;
    int wstride = 6144; asm volatile("" : "+s"(wstride));
#pragma unroll 16
    for (int k = 0; k < 128; ++k) {
        const float wv = __builtin_nontemporal_load(wp + (size_t)(k * wstride));
        const int kk = kg * 128 + k;
        a0 += ssil[kk] * wv; a1 += ssil[1024 + kk] * wv; a2 += ssil[2048 + kk] * wv; a3 += ssil[3072 + kk] * wv; a4 += ssil[4096 + kk] * wv;
    }
    red[(kg * 5 + 0) * 32 + cj] = a0; red[(kg * 5 + 1) * 32 + cj] = a1; red[(kg * 5 + 2) * 32 + cj] = a2;
    red[(kg * 5 + 3) * 32 + cj] = a3; red[(kg * 5 + 4) * 32 + cj] = a4;
    __syncthreads();
    if (t < 160) {
        const int i = t >> 5, cc = t & 31;
        float s = p->in[8][l * 6144 + c0 + cc];
#pragma unroll
        for (int g = 0; g < 8; ++g) s += red[(g * 5 + i) * 32 + cc];
        ((float*)(p->ws + WS_MOD))[(l * 5 + i) * 6144 + c0 + cc] = s;
    }
    __syncthreads();
}

constexpr int CONV_ITEMS = 3001;
__device__ __forceinline__ void conv_item(PP p, int l, int it, unsigned char* smem) {
    const int t = opaque_tid();
    const float* W; int N, K, mat, idx; bf16_t* dst; const float* ksc = nullptr;
    if (it < 552) { mat = 0; idx = it; W = p->in[11] + (size_t)l * 1024 * 2208; N = 2208; K = 1024; dst = (bf16_t*)(p->ws + WS_WIN); }
    else if (it < 600) { mat = 1; idx = it - 552; W = p->in[14] + (size_t)l * 256 * 768; N = 768; K = 256; dst = (bf16_t*)(p->ws + WS_WQUP); ksc = p->in[12] + l * 256; }
    else if (it < 632) { mat = 2; idx = it - 600; W = p->in[15] + (size_t)l * 128 * 1024; N = 1024; K = 128; dst = (bf16_t*)(p->ws + WS_WKV); }
    else if (it < 888) { mat = 3; idx = it - 632; W = p->in[21] + (size_t)l * 1024 * 1024; N = 1024; K = 1024; dst = (bf16_t*)(p->ws + WS_WO); }
    else if (it < 1592) { mat = 4; idx = it - 888; W = p->in[22] + (size_t)l * 1024 * 2816; N = 2816; K = 1024; dst = (bf16_t*)(p->ws + WS_WGU); }
    else if (it < 2296) { mat = 5; idx = it - 1592; W = p->in[23] + (size_t)l * 1024 * 2816; N = 2816; K = 1024; dst = (bf16_t*)(p->ws + WS_WGU); }
    else if (it < 3000) { mat = 6; idx = it - 2296; W = p->in[24] + (size_t)l * 2816 * 1024; N = 1024; K = 2816; dst = (bf16_t*)(p->ws + WS_WDN); }
    else {
        uint4* z = (uint4*)(p->ws + WS_WIN + (size_t)2208 * 1024 * 2);
        unsigned zz = 0u; asm volatile("" : "+v"(zz));
        for (int i = t; i < 96 * 1024 * 2 / 16; i += 256) z[i] = make_uint4(zz, zz, zz, zz);
        return;
    }
    const int nNt = N >> 5;
    const int nt = idx % nNt, kt = idx / nNt;
    const int k0 = kt * 128 + (t >> 5) * 16, c = nt * 32 + (t & 31);
    const float* src = W + (size_t)k0 * N + c;
    float v[16];
#pragma unroll
    for (int j = 0; j < 16; ++j) v[j] = __builtin_nontemporal_load(src + (size_t)j * N);
    if (ksc) {
#pragma unroll
        for (int j = 0; j < 16; j += 4) { const float4 s4 = *(const float4*)(ksc + k0 + j); v[j] *= s4.x; v[j + 1] *= s4.y; v[j + 2] *= s4.z; v[j + 3] *= s4.w; }
    }
    int orow;
    if (mat == 2) { const int h = c >> 7, j = c & 127; orow = j < 64 ? h * 64 + j : 512 + h * 64 + (j - 64); }
    else if (mat == 4) { orow = (c >> 5) * 64 + (c & 31); }
    else if (mat == 5) { orow = (c >> 5) * 64 + 32 + (c & 31); }
    else orow = c;
    uint4 o0, o1;
    o0.x = pack2(v[0], v[1]); o0.y = pack2(v[2], v[3]); o0.z = pack2(v[4], v[5]); o0.w = pack2(v[6], v[7]);
    o1.x = pack2(v[8], v[9]); o1.y = pack2(v[10], v[11]); o1.z = pack2(v[12], v[13]); o1.w = pack2(v[14], v[15]);
    bf16_t* d = dst + (size_t)orow * K + k0;
    *(uint4*)d = o0; *(uint4*)(d + 8) = o1;
}

__device__ __forceinline__ void norm_item(PP p, int l, int it, int which  ) {
    const int t = opaque_tid(), lane = t & 63, w = t >> 6;
    const int m0 = it * 8 + w * 2;
    const float* src0;
    if (which == 0 && l == 0) src0 = m0 < 8192 ? p->in[0] + (size_t)m0 * 1024 : p->in[1] + (size_t)(m0 - 8192) * 1024;
    else src0 = p->out + (size_t)m0 * 1024;
    float4 x[2][4];
#pragma unroll
    for (int r = 0; r < 2; ++r)
#pragma unroll
        for (int i = 0; i < 4; ++i) x[r][i] = *(const float4*)(src0 + r * 1024 + lane * 4 + 256 * i);
    const int cond = m0 < 8192 ? 0 : 1 + ((m0 - 8192) >> 11);
    const float* mod = (const float*)(p->ws + WS_MOD) + (l * 5 + cond) * 6144 + which * 3072;
    const float* g = (which == 0 ? p->in[9] : p->in[10]) + l * 1024;
    float ss0 = 0.f, ss1 = 0.f;
#pragma unroll
    for (int i = 0; i < 4; ++i) {
        ss0 += x[0][i].x * x[0][i].x + x[0][i].y * x[0][i].y + x[0][i].z * x[0][i].z + x[0][i].w * x[0][i].w;
        ss1 += x[1][i].x * x[1][i].x + x[1][i].y * x[1][i].y + x[1][i].z * x[1][i].z + x[1][i].w * x[1][i].w;
    }
#pragma unroll
    for (int o = 32; o; o >>= 1) { ss0 += __shfl_xor(ss0, o); ss1 += __shfl_xor(ss1, o); }
    const float rs0 = rsqrtf(ss0 * (1.f / 1024.f) + EPS), rs1 = rsqrtf(ss1 * (1.f / 1024.f) + EPS);
    bf16_t* dst = (bf16_t*)(p->ws + WS_HM) + (size_t)m0 * 1024;
#pragma unroll
    for (int i = 0; i < 4; ++i) {
        const int col = lane * 4 + 256 * i;
        const float4 gv = *(const float4*)(g + col), sh = *(const float4*)(mod + col), sc = *(const float4*)(mod + 1024 + col);
        const float a0 = gv.x * (1.f + sc.x), a1 = gv.y * (1.f + sc.y), a2 = gv.z * (1.f + sc.z), a3 = gv.w * (1.f + sc.w);
        uint2 o0, o1;
        o0.x = pack2(x[0][i].x * rs0 * a0 + sh.x, x[0][i].y * rs0 * a1 + sh.y); o0.y = pack2(x[0][i].z * rs0 * a2 + sh.z, x[0][i].w * rs0 * a3 + sh.w);
        o1.x = pack2(x[1][i].x * rs1 * a0 + sh.x, x[1][i].y * rs1 * a1 + sh.y); o1.y = pack2(x[1][i].z * rs1 * a2 + sh.z, x[1][i].w * rs1 * a3 + sh.w);
        *(uint2*)(dst + col) = o0;
        *(uint2*)(dst + 1024 + col) = o1;
    }
}

__device__ __forceinline__ float log_sigmoid(float x) { return -log1pf(expf(-x)); }

__device__ __forceinline__ void phaseC_item(PP p, int l, int it, unsigned char* smem) {
    const int c = it >> 2, hs = it & 3;
    const int t = opaque_tid(), lane = t & 63, w = t >> 6;
    const bf16_t* PROJ = (const bf16_t*)(p->ws + WS_PROJ);
    bf16_t* CKV = (bf16_t*)(p->ws + WS_CKV);
    bf16_t* MIX = (bf16_t*)(p->ws + WS_HM);
    float* MSQ = (float*)(p->ws + WS_MSQ);
    constexpr int UROW = 272, UKF = 0, UKB = 64 * UROW, UVT = 128 * UROW;
    {
        const float lgf = log_sigmoid(p->in[19][l * 4 + hs]), lgb = log_sigmoid(p->in[20][l * 4 + hs]);
#pragma unroll
        for (int i = 0; i < 4; ++i) {
            const int idx = t + 256 * i, a = idx >> 3, cc = (idx & 7) * 8;
            const bf16_t* pr = PROJ + (size_t)(c * 128 + a) * INC + hs * 64 + cc;
            const uint4 kv = *(const uint4*)(pr + 1440), vv = *(const uint4*)(pr + 1696);
            const float df = expf(lgf * (float)(127 - a)) * 0.125f, db = expf(lgb * (float)a) * 0.125f;
            const float kx[8] = {bflo(kv.x), bfhi(kv.x), bflo(kv.y), bfhi(kv.y), bflo(kv.z), bfhi(kv.z), bflo(kv.w), bfhi(kv.w)};
            const unsigned vw[4] = {vv.x, vv.y, vv.z, vv.w};
            bf16_t* kf = (bf16_t*)(smem + UKF) + a; bf16_t* kb = (bf16_t*)(smem + UKB) + a; bf16_t* vt = (bf16_t*)(smem + UVT) + a;
#pragma unroll
            for (int j = 0; j < 8; j += 2) {
                const unsigned pf = pack2(kx[j] * df, kx[j + 1] * df), pb = pack2(kx[j] * db, kx[j + 1] * db);
                kf[(cc + j) * (UROW / 2)] = (bf16_t)(pf & 0xffffu); kf[(cc + j + 1) * (UROW / 2)] = (bf16_t)(pf >> 16);
                kb[(cc + j) * (UROW / 2)] = (bf16_t)(pb & 0xffffu); kb[(cc + j + 1) * (UROW / 2)] = (bf16_t)(pb >> 16);
                vt[(cc + j) * (UROW / 2)] = (bf16_t)(vw[j >> 1] & 0xffffu); vt[(cc + j + 1) * (UROW / 2)] = (bf16_t)(vw[j >> 1] >> 16);
            }
        }
    }
    const float* kvg = p->in[13] + l * 128;
    const float* cw = p->in[18] + l * 768;
    for (int tt = 0; tt < 8; ++tt) {
        const int m = c * 128 + hs * 32 + w * 8 + tt;
        const bf16_t* pr = PROJ + (size_t)m * INC;
        const uint2 qv = *(const uint2*)(pr + lane * 4);
        const float q0 = bflo(qv.x), q1 = bfhi(qv.x), q2 = bflo(qv.y), q3 = bfhi(qv.y);
        const float ssq = wave_sum(q0 * q0 + q1 * q1 + q2 * q2 + q3 * q3);
        if (lane == 0) MSQ[m] = ssq * (1.f / 256.f) + EPS;
        const unsigned kvv = *(const unsigned*)(pr + 256 + lane * 2);
        const float k0 = bflo(kvv), k1 = bfhi(kvv);
        const float s2 = wave_sum(k0 * k0 + k1 * k1);
        const float rs = rsqrtf(s2 * (1.f / 128.f) + EPS);
        const float c0v = k0 * rs * kvg[lane * 2], c1v = k1 * rs * kvg[lane * 2 + 1];
        const bool ctx = m < 8192;
        const int kvrow = ctx ? m : m + ((m - 8192) >> 11) * 256;
        *(unsigned*)(CKV + (size_t)kvrow * 128 + lane * 2) = pack2(c0v, c1v);
        if (ctx) {
            const int b = m >> 8, tq = m & 255;
            const size_t orow = (size_t)((b * 2 + l) * 256 + tq);
            *(float2*)(p->out + OUT_CKV + orow * 128 + lane * 2) = make_float2(c0v, c1v);
            if (lane < 32) p->out[OUT_KPE + orow * 32 + lane] = bf2f(pr[384 + lane]);
        }
        const int tseq = ctx ? (m & 255) : ((m - 8192) & 2047);
        const int tlen = ctx ? 256 : 2048;
        const int ch = lane * 4;
        const uint2 gbv = *(const uint2*)(pr + 416 + ch);
        const uint2 gcv = *(const uint2*)(pr + 672 + ch), xv = *(const uint2*)(pr + 928 + ch);
        float uc[4] = {bflo(gcv.x) * bflo(xv.x), bfhi(gcv.x) * bfhi(xv.x), bflo(gcv.y) * bflo(xv.y), bfhi(gcv.y) * bfhi(xv.y)};
        float up[4] = {0.f, 0.f, 0.f, 0.f}, un[4] = {0.f, 0.f, 0.f, 0.f};
        if (tseq > 0) {
            const uint2 g2 = *(const uint2*)(pr - INC + 672 + ch), x2 = *(const uint2*)(pr - INC + 928 + ch);
            up[0] = bflo(g2.x) * bflo(x2.x); up[1] = bfhi(g2.x) * bfhi(x2.x); up[2] = bflo(g2.y) * bflo(x2.y); up[3] = bfhi(g2.y) * bfhi(x2.y);
        }
        if (tseq < tlen - 1) {
            const uint2 g2 = *(const uint2*)(pr + INC + 672 + ch), x2 = *(const uint2*)(pr + INC + 928 + ch);
            un[0] = bflo(g2.x) * bflo(x2.x); un[1] = bfhi(g2.x) * bfhi(x2.x); un[2] = bflo(g2.y) * bflo(x2.y); un[3] = bfhi(g2.y) * bfhi(x2.y);
        }
        const float4 w0 = *(const float4*)(cw + ch), w1 = *(const float4*)(cw + 256 + ch), w2 = *(const float4*)(cw + 512 + ch);
        const float y0 = bflo(gbv.x) * (w0.x * up[0] + w1.x * uc[0] + w2.x * un[0]);
        const float y1 = bfhi(gbv.x) * (w0.y * up[1] + w1.y * uc[1] + w2.y * un[1]);
        const float y2 = bflo(gbv.y) * (w0.z * up[2] + w1.z * uc[2] + w2.z * un[2]);
        const float y3 = bfhi(gbv.y) * (w0.w * up[3] + w1.w * uc[3] + w2.w * un[3]);
        uint2 o; o.x = pack2(y0, y1); o.y = pack2(y2, y3);
        *(uint2*)(MIX + (size_t)m * 1024 + 512 + ch) = o;
    }
    {
        const int j2 = it * 2 + (t >> 7), col = t & 127;
        const int b = j2 >> 8, j = j2 & 255;
        const float v = p->in[2][((size_t)((b * 2 + l) * 256 + j)) * 128 + col];
        CKV[(size_t)(8192 + b * 2304 + 2048 + j) * 128 + col] = (bf16_t)(pack2(v, v) & 0xffffu);
    }
    __syncthreads();
    {
        const int l15 = lane & 15, lq = lane >> 4;
        f32x4 uf[4], ub[4];
#pragma unroll
        for (int ni = 0; ni < 4; ++ni) { uf[ni] = (f32x4){0.f, 0.f, 0.f, 0.f}; ub[ni] = (f32x4){0.f, 0.f, 0.f, 0.f}; }
#pragma unroll
        for (int ks = 0; ks < 4; ++ks) {
            const unsigned ko = (ks * 32 + lq * 8) * 2;
            const bf16x8 af = *(const bf16x8*)(smem + UKF + (w * 16 + l15) * UROW + ko);
            const bf16x8 ab = *(const bf16x8*)(smem + UKB + (w * 16 + l15) * UROW + ko);
#pragma unroll
            for (int ni = 0; ni < 4; ++ni) {
                const bf16x8 vf = *(const bf16x8*)(smem + UVT + (ni * 16 + l15) * UROW + ko);
                uf[ni] = __builtin_amdgcn_mfma_f32_16x16x32_bf16(af, vf, uf[ni], 0, 0, 0);
                ub[ni] = __builtin_amdgcn_mfma_f32_16x16x32_bf16(ab, vf, ub[ni], 0, 0, 0);
            }
        }
        float* U = (float*)(p->ws + WS_U) + (size_t)((c * 4 + hs) * 2) * 4096;
#pragma unroll
        for (int ni = 0; ni < 4; ++ni)
#pragma unroll
            for (int r = 0; r < 4; ++r) {
                const int o = (w * 16 + lq * 4 + r) * 64 + ni * 16 + l15;
                U[o] = uf[ni][r]; U[4096 + o] = ub[ni][r];
            }
    }
    __syncthreads();
}

__device__ __forceinline__ void phaseE_item(PP p, int l, int it) {
    const int t = opaque_tid(), lane = t & 63, w = t >> 6;
    const int row = it * 4 + w;
    const int h = lane >> 3, pp = lane & 7;
    const bf16_t* PROJ = (const bf16_t*)(p->ws + WS_PROJ);
    const bf16_t* KRAW = (const bf16_t*)(p->ws + WS_KRAW);
    bf16_t* KB = (bf16_t*)(p->ws + WS_KB);
    float kp[4]; bool rope = false; int trow = 0, tcol = 0;
    int msrc = -1; size_t csrc = 0;
    if (row < 8192) msrc = row;
    else {
        const int r2 = row - 8192, b = r2 / 2304, tt = r2 - b * 2304;
        if (tt < 2048) { msrc = 8192 + b * 2048 + tt; rope = true; trow = tt >> 6; tcol = tt & 63; }
        else csrc = ((size_t)((b * 2 + l) * 256 + (tt - 2048))) * 32;
    }
    if (msrc >= 0) {
        const uint2 v = *(const uint2*)(PROJ + (size_t)msrc * INC + 384 + pp * 4);
        kp[0] = bflo(v.x); kp[1] = bfhi(v.x); kp[2] = bflo(v.y); kp[3] = bfhi(v.y);
    } else {
        const float4 v = *(const float4*)(p->in[3] + csrc + pp * 4);
        kp[0] = v.x; kp[1] = v.y; kp[2] = v.z; kp[3] = v.w;
    }
    const uint4 kn4 = *(const uint4*)(KRAW + (size_t)row * 512 + h * 64 + pp * 8);
    float kn[8] = {bflo(kn4.x), bfhi(kn4.x), bflo(kn4.y), bfhi(kn4.y), bflo(kn4.z), bfhi(kn4.z), bflo(kn4.w), bfhi(kn4.w)};
    float ss = 0.f;
#pragma unroll
    for (int j = 0; j < 8; ++j) ss += kn[j] * kn[j];
#pragma unroll
    for (int j = 0; j < 4; ++j) ss += kp[j] * kp[j];
    ss += __shfl_xor(ss, 1); ss += __shfl_xor(ss, 2); ss += __shfl_xor(ss, 4);
    const float rs = rsqrtf(ss * (1.f / 96.f) + EPS);
    const float* g = p->in[17] + l * 96;
#pragma unroll
    for (int j = 0; j < 8; ++j) kn[j] *= rs * g[pp * 8 + j];
#pragma unroll
    for (int j = 0; j < 4; ++j) kp[j] *= rs * g[64 + pp * 4 + j];
    float pv[4];
#pragma unroll
    for (int j = 0; j < 4; ++j) pv[j] = __shfl_xor(kp[j], 2);
    if (rope) {
        const int pos = pp < 4 ? trow : tcol;
#pragma unroll
        for (int j = 0; j < 4; ++j) {
            float cs, sn; rope_cs(pos, 4 * (pp & 1) + j, cs, sn);
            kp[j] = (pp & 2) ? (kp[j] * cs + pv[j] * sn) : (kp[j] * cs - pv[j] * sn);
        }
    }
    bf16_t* dst = KB + (size_t)row * 768 + h * 96;
    uint4 o; o.x = pack2(kn[0], kn[1]); o.y = pack2(kn[2], kn[3]); o.z = pack2(kn[4], kn[5]); o.w = pack2(kn[6], kn[7]);
    *(uint4*)(dst + pp * 8) = o;
    uint2 o2; o2.x = pack2(kp[0], kp[1]); o2.y = pack2(kp[2], kp[3]);
    *(uint2*)(dst + 64 + pp * 4) = o2;
}

constexpr int AT_KROW = 208, AT_VROW = 136, AT_VOFF = 64 * AT_KROW, AT_BUF = AT_VOFF + 64 * AT_VROW;
__device__ __forceinline__ void attn_item(PP p, int l, int ait, unsigned char* smem) {
    const int t = opaque_tid(), lane = t & 63, w = t >> 6, half = lane >> 5, ql = lane & 31;
    const bool lat = ait < 512;
    int b, h, qb, mq0, kv0, ntile;
    if (lat) { b = ait >> 7; h = (ait >> 4) & 7; qb = ait & 15; mq0 = 8192 + b * 2048 + qb * 128; kv0 = 8192 + b * 2304; ntile = 36; }
    else { const int i2 = ait - 512; b = i2 >> 4; h = (i2 >> 1) & 7; qb = i2 & 1; mq0 = b * 256 + qb * 128; kv0 = b * 256; ntile = 4; }
    const int m = mq0 + w * 32 + ql;
    const bf16_t* KBp = (const bf16_t*)(p->ws + WS_KB) + (size_t)kv0 * 768 + h * 96;
    const bf16_t* VTp = (const bf16_t*)(p->ws + WS_VT) + (size_t)(h * 64) * NKV + kv0;
    const int kr0 = t / 12, kc0 = t - kr0 * 12, kr1 = (t + 256) / 12, kc1 = (t + 256) - kr1 * 12, kr2 = (t + 512) / 12, kc2 = (t + 512) - kr2 * 12;
    const int vd0 = t >> 3, vd1 = (t + 256) >> 3, vc = t & 7;
    const unsigned kg0 = kr0 * 768 + kc0 * 8, kg1 = kr1 * 768 + kc1 * 8, kg2 = kr2 * 768 + kc2 * 8;
    const unsigned vg0 = vd0 * NKV + vc * 8, vg1 = vd1 * NKV + vc * 8;
    const unsigned kl0 = kr0 * AT_KROW + kc0 * 16, kl1 = kr1 * AT_KROW + kc1 * 16, kl2 = kr2 * AT_KROW + kc2 * 16;
    const unsigned vl0 = AT_VOFF + vd0 * AT_VROW + vc * 16, vl1 = AT_VOFF + vd1 * AT_VROW + vc * 16;
    bf16x8 qf[6];
    {
        const bf16_t* qsrc = (const bf16_t*)(p->ws + WS_QRAW) + (size_t)m * 768 + h * 96 + half * 8;
        float qv[6][8];
        float ss = 0.f;
#pragma unroll
        for (int ks = 0; ks < 6; ++ks) {
            const uint4 u = *(const uint4*)(qsrc + ks * 16);
            qv[ks][0] = bflo(u.x); qv[ks][1] = bfhi(u.x); qv[ks][2] = bflo(u.y); qv[ks][3] = bfhi(u.y);
            qv[ks][4] = bflo(u.z); qv[ks][5] = bfhi(u.z); qv[ks][6] = bflo(u.w); qv[ks][7] = bfhi(u.w);
#pragma unroll
            for (int j = 0; j < 8; ++j) ss += qv[ks][j] * qv[ks][j];
        }
        ss += __shfl_xor(ss, 32);
        const float msq = ((const float*)(p->ws + WS_MSQ))[m];
        const float rs = rsqrtf(ss * (1.f / 96.f) + EPS * msq);
        const float* qg = p->in[16] + l * 96 + half * 8;
#pragma unroll
        for (int ks = 0; ks < 6; ++ks)
#pragma unroll
            for (int j = 0; j < 8; ++j) qv[ks][j] *= rs * qg[ks * 16 + j];
        if (lat) {
            const int tt = qb * 128 + w * 32 + ql;
#pragma unroll
            for (int ks = 4; ks < 6; ++ks) {
                const int pos = ks == 4 ? (tt >> 6) : (tt & 63);
#pragma unroll
                for (int j = 0; j < 8; ++j) {
                    const float pv = __shfl_xor(qv[ks][j], 32);
                    float cs, sn; rope_cs(pos, j, cs, sn);
                    qv[ks][j] = half ? (qv[ks][j] * cs + pv * sn) : (qv[ks][j] * cs - pv * sn);
                }
            }
        }
        constexpr float QS = 0.10206207261596577f * 1.4426950408889634f;
#pragma unroll
        for (int ks = 0; ks < 6; ++ks)
            qf[ks] = mk8(pack2(qv[ks][0] * QS, qv[ks][1] * QS), pack2(qv[ks][2] * QS, qv[ks][3] * QS),
                         pack2(qv[ks][4] * QS, qv[ks][5] * QS), pack2(qv[ks][6] * QS, qv[ks][7] * QS));
    }
    uint4 r0k0, r0k1, r0k2, r0v0, r0v1, r1k0, r1k1, r1k2, r1v0, r1v1, r2k0, r2k1, r2k2, r2v0, r2v1;
#define A_LOAD(P, JT) { \
        const int jt_ = (JT) < ntile ? (JT) : ntile - 1; \
        const bf16_t* kp_ = KBp + (size_t)jt_ * (64 * 768); const bf16_t* vp_ = VTp + jt_ * 64; \
        P##k0 = *(const uint4*)(kp_ + kg0); P##k1 = *(const uint4*)(kp_ + kg1); P##k2 = *(const uint4*)(kp_ + kg2); \
        P##v0 = *(const uint4*)(vp_ + vg0); P##v1 = *(const uint4*)(vp_ + vg1); }
#define A_WRITE(P, STG) { \
        unsigned char* nb_ = smem + (STG) * AT_BUF; \
        *(uint4*)(nb_ + kl0) = P##k0; *(uint4*)(nb_ + kl1) = P##k1; *(uint4*)(nb_ + kl2) = P##k2; \
        *(uint2*)(nb_ + vl0) = make_uint2(P##v0.x, P##v0.y); *(uint2*)(nb_ + vl0 + 8) = make_uint2(P##v0.z, P##v0.w); \
        *(uint2*)(nb_ + vl1) = make_uint2(P##v1.x, P##v1.y); *(uint2*)(nb_ + vl1 + 8) = make_uint2(P##v1.z, P##v1.w); }
    A_LOAD(r0, 0);
    A_WRITE(r0, 0);
    A_LOAD(r1, 1);
    A_LOAD(r2, 2);
    __syncthreads();
    f32x16 o0, o1;
#pragma unroll
    for (int r = 0; r < 16; ++r) { o0[r] = 0.f; o1[r] = 0.f; }
    float mrun = -INFINITY, lrun = 0.f;
    const unsigned kfo = ql * AT_KROW + half * 16, vfo = AT_VOFF + ql * AT_VROW + half * 8;
#define A_COMPUTE(STG) { \
        const unsigned char* cur = smem + (STG) * AT_BUF; \
        f32x16 s0, s1; \
        _Pragma("unroll") for (int r = 0; r < 16; ++r) { s0[r] = 0.f; s1[r] = 0.f; } \
        _Pragma("unroll") for (int ks = 0; ks < 6; ++ks) { \
            const bf16x8 k0 = *(const bf16x8*)(cur + kfo + ks * 32); \
            const bf16x8 k1 = *(const bf16x8*)(cur + kfo + 32 * AT_KROW + ks * 32); \
            s0 = __builtin_amdgcn_mfma_f32_32x32x16_bf16(k0, qf[ks], s0, 0, 0, 0); \
            s1 = __builtin_amdgcn_mfma_f32_32x32x16_bf16(k1, qf[ks], s1, 0, 0, 0); } \
        float mx = fmaxf(s0[0], s1[0]); \
        _Pragma("unroll") for (int r = 1; r < 16; ++r) mx = fmaxf(mx, fmaxf(s0[r], s1[r])); \
        mx = fmaxf(mx, __shfl_xor(mx, 32)); \
        const float mnew = fmaxf(mrun, mx); \
        const float alpha = fexp2(mrun - mnew); \
        mrun = mnew; \
        float ls = 0.f; \
        _Pragma("unroll") for (int r = 0; r < 16; ++r) { s0[r] = fexp2(s0[r] - mnew); s1[r] = fexp2(s1[r] - mnew); ls += s0[r] + s1[r]; } \
        lrun = lrun * alpha + ls; \
        if (__any(alpha != 1.f)) { \
            _Pragma("unroll") for (int r = 0; r < 16; ++r) { o0[r] *= alpha; o1[r] *= alpha; } } \
        _Pragma("unroll") for (int s2 = 0; s2 < 4; ++s2) { \
            const int rb = 8 * (s2 & 1); \
            bf16x8 pf; \
            if (s2 < 2) pf = mk8(pack2(s0[rb + 0], s0[rb + 1]), pack2(s0[rb + 2], s0[rb + 3]), pack2(s0[rb + 4], s0[rb + 5]), pack2(s0[rb + 6], s0[rb + 7])); \
            else pf = mk8(pack2(s1[rb + 0], s1[rb + 1]), pack2(s1[rb + 2], s1[rb + 3]), pack2(s1[rb + 4], s1[rb + 5]), pack2(s1[rb + 6], s1[rb + 7])); \
            const unsigned char* va = cur + vfo + (16 * s2) * 2; \
            const uint2 a0 = *(const uint2*)va, a1 = *(const uint2*)(va + 16); \
            const uint2 b0 = *(const uint2*)(va + 32 * AT_VROW), b1 = *(const uint2*)(va + 32 * AT_VROW + 16); \
            o0 = __builtin_amdgcn_mfma_f32_32x32x16_bf16(mk8(a0.x, a0.y, a1.x, a1.y), pf, o0, 0, 0, 0); \
            o1 = __builtin_amdgcn_mfma_f32_32x32x16_bf16(mk8(b0.x, b0.y, b1.x, b1.y), pf, o1, 0, 0, 0); } }
    for (int j = 0; j < ntile; j += 3) {
        A_LOAD(r0, j + 3);
        A_COMPUTE(0);
        if (j + 1 < ntile) A_WRITE(r1, 1);
        __syncthreads();
        A_LOAD(r1, j + 4);
        if (j + 1 < ntile) A_COMPUTE(1);
        if (j + 2 < ntile) A_WRITE(r2, 2);
        __syncthreads();
        A_LOAD(r2, j + 5);
        if (j + 2 < ntile) A_COMPUTE(2);
        if (j + 3 < ntile) A_WRITE(r0, 0);
        __syncthreads();
    }
    asm volatile("s_waitcnt vmcnt(0)" ::: "memory");
#undef A_LOAD
#undef A_WRITE
#undef A_COMPUTE
    const float ltot = lrun + __shfl_xor(lrun, 32);
    const float inv = 1.f / ltot;
    bf16_t* dst = (bf16_t*)(p->ws + WS_HM) + (size_t)m * 1024 + h * 64;
#pragma unroll
    for (int g = 0; g < 4; ++g) {
        uint2 v; v.x = pack2(o0[4 * g] * inv, o0[4 * g + 1] * inv); v.y = pack2(o0[4 * g + 2] * inv, o0[4 * g + 3] * inv);
        *(uint2*)(dst + 8 * g + 4 * half) = v;
        uint2 u; u.x = pack2(o1[4 * g] * inv, o1[4 * g + 1] * inv); u.y = pack2(o1[4 * g + 2] * inv, o1[4 * g + 3] * inv);
        *(uint2*)(dst + 32 + 8 * g + 4 * half) = u;
    }
}

constexpr int RT_KROW = 144, RT_VROW = 264, RT_SROW = 144;
constexpr int RT_KOFF = 0, RT_VOFF = 128 * RT_KROW, RT_SFOFF = RT_VOFF + 64 * RT_VROW, RT_SBOFF = RT_SFOFF + 64 * RT_SROW;
__device__ __forceinline__ void ret_item(PP p, int l, int rit, unsigned char* smem) {
    const int c = rit >> 2, h = rit & 3;
    const int t = opaque_tid(), lane = t & 63, w = t >> 6, half = lane >> 5, ql = lane & 31;
    const bool ctx = c < 64;
    int b, ci, n, cbase;
    if (ctx) { b = c >> 1; ci = c & 1; n = 2; cbase = c - ci; }
    else { const int c2 = c - 64; b = c2 >> 4; ci = c2 & 15; n = 16; cbase = c - ci; }
    const bf16_t* PROJ = (const bf16_t*)(p->ws + WS_PROJ);
    const float lgf = log_sigmoid(p->in[19][l * 4 + h]), lgb = log_sigmoid(p->in[20][l * 4 + h]);
    const float cf = expf(lgf * 128.f), cb = expf(lgb * 128.f);
    const float lgf2 = lgf * 1.4426950408889634f, lgb2 = lgb * 1.4426950408889634f;
#pragma unroll
    for (int i = 0; i < 4; ++i) {
        const int idx = t + 256 * i, a = idx >> 3, cc = idx & 7;
        const bf16_t* pr = PROJ + (size_t)(c * 128 + a) * INC + h * 64 + cc * 8;
        const uint4 kv = *(const uint4*)(pr + 1440), vv = *(const uint4*)(pr + 1696);
        *(uint4*)(smem + RT_KOFF + a * RT_KROW + cc * 16) = kv;
        bf16_t* vt = (bf16_t*)(smem + RT_VOFF) + a;
        const int d0 = cc * 8;
        vt[(d0 + 0) * (RT_VROW / 2)] = (bf16_t)(vv.x & 0xffffu); vt[(d0 + 1) * (RT_VROW / 2)] = (bf16_t)(vv.x >> 16);
        vt[(d0 + 2) * (RT_VROW / 2)] = (bf16_t)(vv.y & 0xffffu); vt[(d0 + 3) * (RT_VROW / 2)] = (bf16_t)(vv.y >> 16);
        vt[(d0 + 4) * (RT_VROW / 2)] = (bf16_t)(vv.z & 0xffffu); vt[(d0 + 5) * (RT_VROW / 2)] = (bf16_t)(vv.z >> 16);
        vt[(d0 + 6) * (RT_VROW / 2)] = (bf16_t)(vv.w & 0xffffu); vt[(d0 + 7) * (RT_VROW / 2)] = (bf16_t)(vv.w >> 16);
    }
    {
        const int e0 = t * 16, dk = e0 >> 6, dv0 = e0 & 63;
        const float* U = (const float*)(p->ws + WS_U);
        float sf[16], sb[16];
        if (ctx) {
#pragma unroll
            for (int j = 0; j < 16; ++j) { sf[j] = 0.f; sb[j] = 0.f; }
        } else {
            const float* s0f = p->in[4] + ((size_t)(((b * 2 + l) * 2 + 0) * 4 + h)) * 4096 + e0;
            const float* s0b = p->in[4] + ((size_t)(((b * 2 + l) * 2 + 1) * 4 + h)) * 4096 + e0;
#pragma unroll
            for (int j = 0; j < 16; j += 4) {
                const float4 a = *(const float4*)(s0f + j), bb = *(const float4*)(s0b + j);
                sf[j] = a.x; sf[j + 1] = a.y; sf[j + 2] = a.z; sf[j + 3] = a.w;
                sb[j] = bb.x; sb[j + 1] = bb.y; sb[j + 2] = bb.z; sb[j + 3] = bb.w;
            }
        }
        for (int jb = 0; jb < ci; jb += 4) {
            float4 ua[4][4];
#pragma unroll
            for (int k = 0; k < 4; ++k) {
                const int jj = jb + k < ci ? jb + k : ci - 1;
                const float* u = U + (size_t)(((cbase + jj) * 4 + h) * 2 + 0) * 4096 + e0;
#pragma unroll
                for (int q = 0; q < 4; ++q) ua[k][q] = *(const float4*)(u + 4 * q);
            }
#pragma unroll
            for (int k = 0; k < 4; ++k)
                if (jb + k < ci) {
#pragma unroll
                    for (int q = 0; q < 4; ++q) { sf[4 * q] = cf * sf[4 * q] + ua[k][q].x; sf[4 * q + 1] = cf * sf[4 * q + 1] + ua[k][q].y; sf[4 * q + 2] = cf * sf[4 * q + 2] + ua[k][q].z; sf[4 * q + 3] = cf * sf[4 * q + 3] + ua[k][q].w; }
                }
        }
        {
            const int cnt = n - 1 - ci;
            for (int jb = 0; jb < cnt; jb += 4) {
                float4 ua[4][4];
#pragma unroll
                for (int k = 0; k < 4; ++k) {
                    const int jj = jb + k < cnt ? n - 1 - (jb + k) : ci + 1;
                    const float* u = U + (size_t)(((cbase + jj) * 4 + h) * 2 + 1) * 4096 + e0;
#pragma unroll
                    for (int q = 0; q < 4; ++q) ua[k][q] = *(const float4*)(u + 4 * q);
                }
#pragma unroll
                for (int k = 0; k < 4; ++k)
                    if (jb + k < cnt) {
#pragma unroll
                        for (int q = 0; q < 4; ++q) { sb[4 * q] = cb * sb[4 * q] + ua[k][q].x; sb[4 * q + 1] = cb * sb[4 * q + 1] + ua[k][q].y; sb[4 * q + 2] = cb * sb[4 * q + 2] + ua[k][q].z; sb[4 * q + 3] = cb * sb[4 * q + 3] + ua[k][q].w; }
                    }
            }
        }
        if (ctx) {
            if (ci == n - 1) {
                const float* u = U + (size_t)((c * 4 + h) * 2 + 0) * 4096 + e0;
                float* o = p->out + OUT_ST + ((size_t)(((b * 2 + l) * 2 + 0) * 4 + h)) * 4096 + e0;
#pragma unroll
                for (int j = 0; j < 16; j += 4) { const float4 a = *(const float4*)(u + j); *(float4*)(o + j) = make_float4(cf * sf[j] + a.x, cf * sf[j + 1] + a.y, cf * sf[j + 2] + a.z, cf * sf[j + 3] + a.w); }
            }
            if (ci == 0) {
                const float* u = U + (size_t)((c * 4 + h) * 2 + 1) * 4096 + e0;
                float* o = p->out + OUT_ST + ((size_t)(((b * 2 + l) * 2 + 1) * 4 + h)) * 4096 + e0;
#pragma unroll
                for (int j = 0; j < 16; j += 4) { const float4 a = *(const float4*)(u + j); *(float4*)(o + j) = make_float4(cb * sb[j] + a.x, cb * sb[j + 1] + a.y, cb * sb[j + 2] + a.z, cb * sb[j + 3] + a.w); }
            }
        }
        bf16_t* sF = (bf16_t*)(smem + RT_SFOFF) + dk; bf16_t* sB = (bf16_t*)(smem + RT_SBOFF) + dk;
#pragma unroll
        for (int j = 0; j < 16; j += 2) {
            const unsigned pf = pack2(sf[j], sf[j + 1]), pb = pack2(sb[j], sb[j + 1]);
            sF[(dv0 + j) * (RT_SROW / 2)] = (bf16_t)(pf & 0xffffu); sF[(dv0 + j + 1) * (RT_SROW / 2)] = (bf16_t)(pf >> 16);
            sB[(dv0 + j) * (RT_SROW / 2)] = (bf16_t)(pb & 0xffffu); sB[(dv0 + j + 1) * (RT_SROW / 2)] = (bf16_t)(pb >> 16);
        }
    }
    const int a = w * 32 + ql;
    const int m = c * 128 + a;
    bf16x8 qf[4];
    {
        const bf16_t* qsrc = PROJ + (size_t)m * INC + 1184 + h * 64 + half * 8;
#pragma unroll
        for (int ks = 0; ks < 4; ++ks) { const uint4 u = *(const uint4*)(qsrc + ks * 16); qf[ks] = mk8(u.x, u.y, u.z, u.w); }
    }
    __syncthreads();
    f32x16 o0, o1;
    {
        f32x16 f0, f1;
#pragma unroll
        for (int r = 0; r < 16; ++r) { f0[r] = 0.f; f1[r] = 0.f; }
#pragma unroll
        for (int ks = 0; ks < 4; ++ks) {
            const int ko = (ks * 16 + half * 8) * 2;
            const bf16x8 sf0 = *(const bf16x8*)(smem + RT_SFOFF + ql * RT_SROW + ko), sf1 = *(const bf16x8*)(smem + RT_SFOFF + (32 + ql) * RT_SROW + ko);
            f0 = __builtin_amdgcn_mfma_f32_32x32x16_bf16(sf0, qf[ks], f0, 0, 0, 0);
            f1 = __builtin_amdgcn_mfma_f32_32x32x16_bf16(sf1, qf[ks], f1, 0, 0, 0);
        }
        const float wf = fexp2(lgf2 * (float)(a + 1));
#pragma unroll
        for (int r = 0; r < 16; ++r) { o0[r] = wf * f0[r]; o1[r] = wf * f1[r]; }
#pragma unroll
        for (int r = 0; r < 16; ++r) { f0[r] = 0.f; f1[r] = 0.f; }
#pragma unroll
        for (int ks = 0; ks < 4; ++ks) {
            const int ko = (ks * 16 + half * 8) * 2;
            const bf16x8 sb0 = *(const bf16x8*)(smem + RT_SBOFF + ql * RT_SROW + ko), sb1 = *(const bf16x8*)(smem + RT_SBOFF + (32 + ql) * RT_SROW + ko);
            f0 = __builtin_amdgcn_mfma_f32_32x32x16_bf16(sb0, qf[ks], f0, 0, 0, 0);
            f1 = __builtin_amdgcn_mfma_f32_32x32x16_bf16(sb1, qf[ks], f1, 0, 0, 0);
        }
        const float wb = fexp2(lgb2 * (float)(128 - a));
#pragma unroll
        for (int r = 0; r < 16; ++r) { o0[r] += wb * f0[r]; o1[r] += wb * f1[r]; }
    }
#pragma unroll 1
    for (int kt2 = 0; kt2 < 4; ++kt2) {
        f32x16 s;
#pragma unroll
        for (int r = 0; r < 16; ++r) s[r] = 0.f;
#pragma unroll
        for (int ks = 0; ks < 4; ++ks) {
            const bf16x8 kf = *(const bf16x8*)(smem + RT_KOFF + (kt2 * 32 + ql) * RT_KROW + (ks * 16 + half * 8) * 2);
            s = __builtin_amdgcn_mfma_f32_32x32x16_bf16(kf, qf[ks], s, 0, 0, 0);
        }
#pragma unroll
        for (int r = 0; r < 16; ++r) {
            const int ap = kt2 * 32 + (r & 3) + 8 * (r >> 2) + 4 * half;
            const int d = a - ap;
            const float dec = d > 0 ? fexp2(lgf2 * (float)d) : (d < 0 ? fexp2(lgb2 * (float)(-d)) : 2.f);
            s[r] = s[r] * dec * 0.125f;
        }
#pragma unroll
        for (int s2 = 0; s2 < 2; ++s2) {
            const int rb = 8 * s2;
            const bf16x8 pf = mk8(pack2(s[rb + 0], s[rb + 1]), pack2(s[rb + 2], s[rb + 3]), pack2(s[rb + 4], s[rb + 5]), pack2(s[rb + 6], s[rb + 7]));
            const int keyb = kt2 * 32 + 16 * s2 + 4 * half;
            const unsigned char* va = smem + RT_VOFF + ql * RT_VROW + keyb * 2;
            const uint2 a0 = *(const uint2*)va, a1 = *(const uint2*)(va + 16);
            const uint2 b0 = *(const uint2*)(va + 32 * RT_VROW), b1 = *(const uint2*)(va + 32 * RT_VROW + 16);
            o0 = __builtin_amdgcn_mfma_f32_32x32x16_bf16(mk8(a0.x, a0.y, a1.x, a1.y), pf, o0, 0, 0, 0);
            o1 = __builtin_amdgcn_mfma_f32_32x32x16_bf16(mk8(b0.x, b0.y, b1.x, b1.y), pf, o1, 0, 0, 0);
        }
    }
    float ss = 0.f;
#pragma unroll
    for (int r = 0; r < 16; ++r) ss += o0[r] * o0[r] + o1[r] * o1[r];
    ss += __shfl_xor(ss, 32);
    const float rs = rsqrtf(ss * (1.f / 64.f) + EPS);
    const bf16_t* rg = PROJ + (size_t)m * INC + 1952 + h * 64;
    bf16_t* dst = (bf16_t*)(p->ws + WS_HM) + (size_t)m * 1024 + 768 + h * 64;
#pragma unroll
    for (int g = 0; g < 4; ++g) {
#pragma unroll
        for (int dt = 0; dt < 2; ++dt) {
            const int dv = dt * 32 + 8 * g + 4 * half;
            const uint2 gv = *(const uint2*)(rg + dv);
            const float g0 = bflo(gv.x), g1 = bfhi(gv.x), g2 = bflo(gv.y), g3 = bfhi(gv.y);
            const float x0 = dt ? o1[4 * g] : o0[4 * g], x1 = dt ? o1[4 * g + 1] : o0[4 * g + 1], x2 = dt ? o1[4 * g + 2] : o0[4 * g + 2], x3 = dt ? o1[4 * g + 3] : o0[4 * g + 3];
            uint2 v;
            v.x = pack2(x0 * rs * (g0 / (1.f + __expf(-g0))), x1 * rs * (g1 / (1.f + __expf(-g1))));
            v.y = pack2(x2 * rs * (g2 / (1.f + __expf(-g2))), x3 * rs * (g3 / (1.f + __expf(-g3))));
            *(uint2*)(dst + dv) = v;
        }
    }
    __syncthreads();
}

constexpr int NPHASE = 19;
__device__ __forceinline__ void run_phase(PP p, int ph, unsigned char* smem) {
    const int vb = opaque_tid_full() >> 8;
    const int G = 2 * gridDim.x, bid = 2 * opaque_bid() + vb;
    unsigned char* vsm = smem + vb * VSMEM;
    if (ph == 0) {
        if (bid < 384) mod_item(p, bid, vsm);
        else { for (int j = 0; j < 5; ++j) conv_item(p, 0, (bid - 384) * 5 + j, vsm); }
        for (int it = 640 + bid; it < CONV_ITEMS; it += G) conv_item(p, 0, it, vsm);
        return;
    }
    const int l = (ph - 1) / 9, s = (ph - 1) % 9;
    float* MOD = (float*)(p->ws + WS_MOD);
    bf16_t* HM = (bf16_t*)(p->ws + WS_HM);
    Epi ep; ep.obf = nullptr; ep.ldc = 0; ep.ncols = 0; ep.X = p->out; ep.xs0 = p->out; ep.xs1 = p->out + (size_t)8192 * 1024; ep.gate = MOD; ep.proj = nullptr; ep.ckpe = nullptr; ep.lyr = l;
    switch (s) {
    case 0: {
        const int nconv = l == 0 ? 0 : CONV_ITEMS;
        for (int it = bid; it < 2048 + nconv; it += G) {
            if (it < 2048) norm_item(p, l, it, 0); else conv_item(p, l, it - 2048, vsm);
        }
    } break;
    case 1: {
        ep.obf = (bf16_t*)(p->ws + WS_PROJ); ep.ldc = INC; ep.ncols = INC;
        gemm_phase<EPI_BF16, true, 3>(HM, 1024, (const bf16_t*)(p->ws + WS_WIN), 1024, NTOK, 2304, 1024, ep, smem);
    } break;
    case 2: {
        for (int it = bid; it < 512; it += G) phaseC_item(p, l, it, vsm);
    } break;
    case 3: {
        ep.obf = (bf16_t*)(p->ws + WS_QRAW); ep.ldc = 768; ep.ncols = 768;
        gemm_phase<EPI_BF16, false>((const bf16_t*)(p->ws + WS_PROJ), INC, (const bf16_t*)(p->ws + WS_WQUP), 256, NTOK, 768, 256, ep, smem);
        ep.obf = (bf16_t*)(p->ws + WS_KB); ep.gate = p->in[17] + l * 96; ep.proj = (const bf16_t*)(p->ws + WS_PROJ); ep.ckpe = p->in[3]; ep.lyr = l;
        gemm_phase<EPI_KHEAD, false>((const bf16_t*)(p->ws + WS_CKV), 128, (const bf16_t*)(p->ws + WS_WKV), 128, NKV, 512, 128, ep, smem, 0, 8);
        ep.obf = (bf16_t*)(p->ws + WS_VT); ep.ldc = NKV; ep.ncols = 512;
        gemm_phase<EPI_VT, false>((const bf16_t*)(p->ws + WS_CKV), 128, (const bf16_t*)(p->ws + WS_WKV) + (size_t)512 * 128, 128, NKV, 512, 128, ep, smem, 0, 22);
    } break;
    case 4: {
        for (int it = bid; it < 1536; it += G) {
            if (it >= 512 && it < 1024) ret_item(p, l, it - 512, vsm);
            else attn_item(p, l, it < 512 ? it : it - 512, vsm);
        }
    } break;
    case 5: {
        if (l == 0) { ep.xs0 = p->in[0]; ep.xs1 = p->in[1]; }
        ep.gate = MOD + l * 5 * 6144 + 2 * 1024;
        gemm_phase<EPI_RESID>(HM, 1024, (const bf16_t*)(p->ws + WS_WO), 1024, NTOK, 1024, 1024, ep, smem);
    } break;
    case 6: {
        for (int it = bid; it < 2048; it += G) norm_item(p, l, it, 1);
    } break;
    case 7: {
        ep.obf = (bf16_t*)(p->ws + WS_ACT); ep.ldc = FFH; ep.ncols = FFH;
        gemm_phase<EPI_SWIGLU, true, 4, 8>(HM, 1024, (const bf16_t*)(p->ws + WS_WGU), 1024, NTOK, 5632, 1024, ep, smem, 1);
        gemm_phase<EPI_SWIGLU, true, 4, 4>(HM, 1024, (const bf16_t*)(p->ws + WS_WGU), 1024, NTOK, 5632, 1024, ep, smem, 2);
    } break;
    case 8: {
        ep.gate = MOD + l * 5 * 6144 + 5 * 1024;
        gemm_phase<EPI_RESID>((const bf16_t*)(p->ws + WS_ACT), FFH, (const bf16_t*)(p->ws + WS_WDN), FFH, NTOK, 1024, FFH, ep, smem);
    } break;
    }
}

__global__ void __launch_bounds__(512, 2) mk_forward(Params p_arg, int ph_lo, int ph_hi) {
    __shared__ __attribute__((aligned(16))) unsigned char smem[SMEM_BYTES];
    PP p = (PP)__builtin_amdgcn_kernarg_segment_ptr();
    volatile LAS unsigned* st = (volatile LAS unsigned*)(smem + SMEM_BYTES - 16);
    const bool multi = (ph_hi - ph_lo) > 1;
    if (multi) {
        if (opaque_tid_full() == 0) { st[0] = 0u; st[1] = 0u; st[2] = 0u; st[3] = 0u; }
        __syncthreads();
        (void)xcd_barrier_post((unsigned*)(p->ws + WS_BAR), st);
    }
#define MK_PH(N) \
    if ((N) >= ph_lo && (N) < ph_hi) { \
        if ((N) > ph_lo) { \
            if (ph_lo > 4096) { __syncthreads(); cg::this_grid().sync(); }     \
            asm volatile("" : "+s"(p)); \
            XcdBarrier xb; xb.bar = (unsigned*)(p->ws + WS_BAR); xb.x = xb_xcc_id(); xb.st = st; \
            xcd_barrier(xb); \
        } \
        asm volatile("" : "+s"(p)); \
        run_phase(p, (N), smem); \
    }
    MK_PH(0) MK_PH(1) MK_PH(2) MK_PH(3) MK_PH(4) MK_PH(5) MK_PH(6) MK_PH(7) MK_PH(8) MK_PH(9)
    MK_PH(10) MK_PH(11) MK_PH(12) MK_PH(13) MK_PH(14) MK_PH(15) MK_PH(16) MK_PH(17) MK_PH(18)
#undef MK_PH
}

extern "C" void kernel_launch(void* const* d_in, const int* in_sizes, int n_in, void* d_out, int out_size, void* d_ws, size_t ws_size, hipStream_t stream) {
    Params p{};
    for (int i = 0; i < 25; ++i) p.in[i] = (const float*)d_in[i];
    p.out = (float*)d_out;
    p.ws = (unsigned char*)d_ws;
    static int grid_blocks = 0;
    if (!grid_blocks) {
        int dev = 0, cus = 0, per_cu = 0;
        hipGetDevice(&dev);
        hipDeviceGetAttribute(&cus, hipDeviceAttributeMultiprocessorCount, dev);
        hipOccupancyMaxActiveBlocksPerMultiprocessor(&per_cu, mk_forward, 512, 0);
        if (per_cu > 1) per_cu = 1;
        if (per_cu < 1) per_cu = 1;
        grid_blocks = cus * per_cu;
    }
    hipMemsetAsync((unsigned char*)d_ws + WS_BAR, 0, 16384, stream);
#if MK_MULTI
    for (int ph = 0; ph < NPHASE; ++ph) hipLaunchKernelGGL(mk_forward, dim3(grid_blocks), dim3(512), 0, stream, p, ph, ph + 1);
#else
    int lo = 0, hi = NPHASE;
    void* args[] = {&p, &lo, &hi};
    hipError_t e = hipLaunchCooperativeKernel((const void*)mk_forward, dim3(grid_blocks), dim3(512), args, 0, stream);
    if (e != hipSuccess) fprintf(stderr, "cooperative launch failed: %s (grid %d)\n", hipGetErrorString(e), grid_blocks);
#endif
}
```

```cpp
#include <hip/hip_runtime.h>
#include <hip/hip_cooperative_groups.h>
#include <stdint.h>
#include <cstdio>
namespace cg = cooperative_groups;

#ifndef MK_MULTI
#define MK_MULTI 0
#endif

typedef unsigned short bf16_t;
typedef short bf16x8 __attribute__((ext_vector_type(8)));
typedef float f32x4 __attribute__((ext_vector_type(4)));
typedef float f32x16 __attribute__((ext_vector_type(16)));
typedef unsigned u32x4 __attribute__((ext_vector_type(4)));
typedef u32x4 __attribute__((may_alias)) u32x4_ma;

constexpr int NTOK = 16384;
constexpr int NKV = 17408;
constexpr int INC = 2208;
constexpr int FFH = 2816;
constexpr float EPS = 1e-6f;

constexpr size_t OUT_CKV = 16777216, OUT_KPE = 18874368, OUT_ST = 19398656;

constexpr size_t WS_BAR = 0;
constexpr size_t WS_MOD = 16384;
constexpr size_t WS_MSQ = WS_MOD + 2 * 5 * 6144 * 4;
constexpr size_t WS_WIN = WS_MSQ + NTOK * 4;
constexpr size_t WS_WQUP = WS_WIN + (size_t)2304 * 1024 * 2;
constexpr size_t WS_WKV = WS_WQUP + (size_t)768 * 256 * 2;
constexpr size_t WS_WO = WS_WKV + (size_t)1024 * 128 * 2;
constexpr size_t WS_WGU = WS_WO + (size_t)1024 * 1024 * 2;
constexpr size_t WS_WDN = WS_WGU + (size_t)5632 * 1024 * 2;
constexpr size_t WS_HM = WS_WDN + (size_t)1024 * 2816 * 2;
constexpr size_t WS_PROJ = WS_HM + (size_t)NTOK * 1024 * 2;
constexpr size_t WS_CKV = WS_PROJ + (size_t)NTOK * INC * 2;
constexpr size_t WS_QRAW = WS_CKV + (size_t)NKV * 128 * 2;
constexpr size_t WS_KRAW = WS_QRAW + (size_t)NTOK * 768 * 2;
constexpr size_t WS_KB = WS_KRAW + (size_t)NKV * 512 * 2;
constexpr size_t WS_VT = WS_KB + (size_t)NKV * 768 * 2;
constexpr size_t WS_U = WS_VT + (size_t)512 * NKV * 2;
constexpr size_t WS_END = WS_U + (size_t)128 * 4 * 2 * 4096 * 4;
constexpr size_t WS_ACT = WS_PROJ;
static_assert((size_t)NTOK * FFH * 2 <= WS_KRAW - WS_PROJ, "ACT overlay");
static_assert(WS_END <= (size_t)256 * 1024 * 1024, "workspace");

constexpr int VSMEM = 67584;
constexpr int SMEM_BYTES = 2 * VSMEM;

struct Params {
    const float* in[25];
    float* out;
    unsigned char* ws;
};
typedef const Params __attribute__((address_space(4)))* PP;

__device__ __forceinline__ float bflo(unsigned u) { return __uint_as_float(u << 16); }
__device__ __forceinline__ float bfhi(unsigned u) { return __uint_as_float(u & 0xffff0000u); }
__device__ __forceinline__ float bf2f(bf16_t b) { return __uint_as_float(((unsigned)b) << 16); }
__device__ __forceinline__ unsigned pack2(float lo, float hi) { unsigned r; asm("v_cvt_pk_bf16_f32 %0, %1, %2" : "=v"(r) : "v"(lo), "v"(hi)); return r; }
__device__ __forceinline__ bf16x8 mk8(unsigned a, unsigned b, unsigned c, unsigned d) { u32x4 v = {a, b, c, d}; return __builtin_bit_cast(bf16x8, v); }
__device__ __forceinline__ float wave_sum(float v) {
#pragma unroll
    for (int o = 32; o; o >>= 1) v += __shfl_xor(v, o);
    return v;
}
__device__ __forceinline__ float fexp2(float x) { return __builtin_amdgcn_exp2f(x); }
__device__ __forceinline__ int opaque_bid() { int b = blockIdx.x; asm volatile("" : "+s"(b)); return b; }
__device__ __forceinline__ int opaque_tid() { int t = threadIdx.x; asm volatile("" : "+v"(t)); return t & 255; }
__device__ __forceinline__ int opaque_tid_full() { int t = threadIdx.x; asm volatile("" : "+v"(t)); return t; }

#define XB_TMO      128
#define XB_XCNT(j)  (256  + 64 * (j))
#define XB_XSUB(j)  (1280 + 64 * (j))
#define XB_XGEN(j)  (2304 + 64 * (j))
#define XB_TOP      3328
#define XB_TOPGEN   3392
#define XCD_BAR_WORDS 3456
#define XB_SPIN_CAP (1u << 22)
#define LAS __attribute__((address_space(3)))
__device__ __forceinline__ unsigned xb_ld(unsigned* p)              { return __hip_atomic_load(p, __ATOMIC_RELAXED, __HIP_MEMORY_SCOPE_AGENT); }
__device__ __forceinline__ unsigned xb_add(unsigned* p, unsigned v) { return __hip_atomic_fetch_add(p, v, __ATOMIC_RELAXED, __HIP_MEMORY_SCOPE_AGENT); }
__device__ __forceinline__ unsigned xb_xcc_id() { return (unsigned)__builtin_amdgcn_s_getreg((3 << 11) | 20) & 0xFu; }
#define XB_SPIN(cond, bar) do { unsigned _sp = 0; while (cond) { __builtin_amdgcn_s_sleep(1); \
    if ((++_sp & 255u) == 0u) { if (xb_ld(&(bar)[XB_TMO])) break; if (_sp > XB_SPIN_CAP) { atomicAdd(&(bar)[XB_TMO], 1u); break; } } } } while (0)
struct XcdBarrier { unsigned* bar; unsigned x; volatile LAS unsigned* st; };
__device__ __forceinline__ XcdBarrier xcd_barrier_post(unsigned* bar, volatile LAS unsigned* st) {
    XcdBarrier b; b.bar = bar; b.x = xb_xcc_id(); b.st = st;
    if (opaque_tid_full() == 0) (void)xb_add(&bar[XB_XCNT(b.x)], 1u);
    return b;
}
__device__ __forceinline__ void xcd_barrier_complete(unsigned* bar, unsigned x, unsigned& nloc, unsigned& nx) {
    const unsigned G = gridDim.x * gridDim.y * gridDim.z;
    unsigned sum, cnt, mine, sp = 0u;
    for (;;) {
        sum = 0u; cnt = 0u; mine = 0u;
#pragma unroll
        for (unsigned j = 0; j < 16; ++j) { const unsigned c = xb_ld(&bar[XB_XCNT(j)]); sum += c; cnt += (c > 0u) ? 1u : 0u; mine = (j == x) ? c : mine; }
        if (sum == G) break;
        __builtin_amdgcn_s_sleep(1);
        if ((++sp & 255u) == 0u) { if (xb_ld(&bar[XB_TMO])) break; if (sp > XB_SPIN_CAP) { atomicAdd(&bar[XB_TMO], 1u); break; } }
    }
    nloc = mine > 0u ? mine : 1u; nx = cnt > 0u ? cnt : 1u;
}
__device__ __forceinline__ void xcd_barrier(const XcdBarrier& b) {
    asm volatile("s_waitcnt vmcnt(0)" ::: "memory");
    __syncthreads();
    if (opaque_tid_full() == 0) {
        unsigned* bar = b.bar;
        __builtin_amdgcn_s_waitcnt(0);
        unsigned nloc = b.st[0], nx = b.st[1];
        if (nloc == 0u) { xcd_barrier_complete(bar, b.x, nloc, nx); b.st[0] = nloc; b.st[1] = nx; }
        const unsigned old = xb_add(&bar[XB_XSUB(b.x)], 1u);
        const unsigned gen = old / nloc;
        if (old + 1u == (gen + 1u) * nloc) {
            __builtin_amdgcn_fence(__ATOMIC_RELEASE, "agent");
            asm volatile("s_waitcnt vmcnt(0)" ::: "memory");
            const unsigned og = xb_add(&bar[XB_TOP], 1u);
            const unsigned tg = og / nx;
            if (og + 1u == (tg + 1u) * nx) xb_add(&bar[XB_TOPGEN], 1u);
            else XB_SPIN(xb_ld(&bar[XB_TOPGEN]) == tg, bar);
            __builtin_amdgcn_fence(__ATOMIC_ACQUIRE, "agent");
            xb_add(&bar[XB_XGEN(b.x)], 1u);
            asm volatile("s_waitcnt vmcnt(0)" ::: "memory");
        } else {
            XB_SPIN(xb_ld(&bar[XB_XGEN(b.x)]) == gen, bar);
            __builtin_amdgcn_fence(__ATOMIC_ACQUIRE, "agent");
            asm volatile("s_waitcnt vmcnt(0)" ::: "memory");
        }
    }
    __syncthreads();
}

__device__ __forceinline__ void rope_cs(int pos, int fi, float& cs, float& sn) {
    const float freq = exp2f(-(float)fi * 1.6609640474436813f);
    const float ang = (float)pos * freq;
    const float rev = ang * 0.15915494309189535f;
    sn = __builtin_amdgcn_sinf(rev); cs = __builtin_amdgcn_cosf(rev);
}

enum { EPI_BF16 = 0, EPI_VT = 1, EPI_RESID = 2, EPI_SWIGLU = 3, EPI_KHEAD = 4 };
struct Epi {
    bf16_t* obf; int ldc; int ncols;
    float* X; const float* xs0; const float* xs1; const float* gate;
    const bf16_t* proj; const float* ckpe; int lyr;
};

__device__ __forceinline__ int swz(int r, int chunk) {
    const int line = r >> 1; int slot = ((r & 1) << 3) | chunk; slot ^= (line & 15);
    return line * 256 + slot * 16;
}

__device__ __forceinline__ bool tile_at(int nM, int nN, int i, int& tm, int& tn) {
    const int xcd = opaque_bid() & 7;
    const int mx = (nM - xcd + 7) >> 3;
    if (i >= mx * nN) return false;
    const int per = mx * 4, nfull = nN >> 2;
    const int c = i / per;
    if (c < nfull) { const int r = i - c * per; tm = xcd + 8 * (r >> 2); tn = c * 4 + (r & 3); }
    else { const int rem = i - nfull * per; const int tw = nN & 3; tm = xcd + 8 * (rem / tw); tn = nfull * 4 + rem % tw; }
    return true;
}


template <int EPI, bool EARLYW = true, int NI = 4, int MI = 8>
__device__ __forceinline__ void gemm_phase(const bf16_t* __restrict__ A, int lda, const bf16_t* __restrict__ B, int ldb, int M, int N, int K,
                                           const Epi& ep, unsigned char* smem, int mode = 0, int rot = 0) {
    const int t = opaque_tid_full(), lane = t & 63, w = t >> 6;
    const int wr = w >> 2, wc = w & 3;
    const int l15 = lane & 15, lq = lane >> 4;
    const int lrow = t >> 3, lch = t & 7;
    constexpr int NT = 64 * NI, WN = 16 * NI, WM = 16 * MI;
    const int nM = M >> 8, nN = N / NT, nk = K >> 6;
    int istep = gridDim.x >> 3;
    int li = ((opaque_bid() >> 3) + rot) % istep, ltm = 0, ltn = 0, lkt = 0, lim, hrow = 0;
    {
        const int xcd = opaque_bid() & 7;
        const int total = ((nM - xcd + 7) >> 3) * nN;
        const int full = (total / istep) * istep;
        if (mode == 2) {
            if (li >= 2 * (total - full)) return;
            hrow = (li & 1) * 128; li = full + (li >> 1); lim = li + 1; istep = 1;
        } else lim = mode == 1 ? full : total;
    }
    if (li >= lim || !tile_at(nM, nN, li, ltm, ltn)) return;
    const int T = ((lim - li + istep - 1) / istep) * nk;
    int ci = li, ctm = ltm, ctn = ltn, ckt = 0;
    u32x4 xa0, xa1, xa2, xa3, xb0, xb1, xb2, xb3;
    f32x4 acc[MI][NI];
    { float z = 0.f; asm volatile("" : "+v"(z));
#pragma unroll
      for (int i = 0; i < MI; ++i)
#pragma unroll
        for (int j = 0; j < NI; ++j) acc[i][j] = (f32x4){z, z, z, z}; }

    const size_t ars = (size_t)lda * 128, brs = (size_t)ldb * 128;
#define G_LOAD() { \
        const int tl_ = opaque_tid_full(); \
        const unsigned ag0 = (unsigned)((tl_ >> 3) * lda + (tl_ & 7) * 8) * 2u, bg0 = (unsigned)((tl_ >> 3) * ldb + (tl_ & 7) * 8) * 2u; \
        const unsigned char* ga_ = (const unsigned char*)(A + (size_t)(ltm * 256 + hrow) * lda + lkt * 64); \
        const unsigned char* gb_ = (const unsigned char*)(B + (size_t)(ltn * NT) * ldb + lkt * 64); \
        xa0 = *(const u32x4_ma*)(ga_ + ag0); xa1 = *(const u32x4_ma*)(ga_ + ars + ag0); if (MI == 8) { xa2 = *(const u32x4_ma*)(ga_ + 2 * ars + ag0); xa3 = *(const u32x4_ma*)(ga_ + 3 * ars + ag0); } \
        xb0 = *(const u32x4_ma*)(gb_ + bg0); xb1 = *(const u32x4_ma*)(gb_ + brs + bg0); xb2 = *(const u32x4_ma*)(gb_ + 2 * brs + bg0); if (NI == 4) xb3 = *(const u32x4_ma*)(gb_ + 3 * brs + bg0); \
        if (++lkt == nk) { lkt = 0; li += istep; if (li < lim) tile_at(nM, nN, li, ltm, ltn); } }
#define G_WRITE(BUF) { \
        const int tw_ = opaque_tid_full(); \
        unsigned char* d_ = smem + (BUF) * 65536 + swz(tw_ >> 3, tw_ & 7); \
        *(u32x4_ma*)(d_) = xa0; *(u32x4_ma*)(d_ + 8192) = xa1; if (MI == 8) { *(u32x4_ma*)(d_ + 16384) = xa2; *(u32x4_ma*)(d_ + 24576) = xa3; } \
        *(u32x4_ma*)(d_ + 32768) = xb0; *(u32x4_ma*)(d_ + 40960) = xb1; *(u32x4_ma*)(d_ + 49152) = xb2; if (NI == 4) *(u32x4_ma*)(d_ + 57344) = xb3; }
#define G_AF(MIX) __builtin_bit_cast(bf16x8, *(const u32x4_ma*)(s_ + (((MIX) & 1) ? fa1_ : fa0_) + ((MIX) >> 1) * 4096))
#define G_MM(MIX, AFR) { _Pragma("unroll") for (int ni = 0; ni < NI; ++ni) { \
            if (EPI == EPI_VT) acc[(MIX) < MI ? (MIX) : 0][ni] = __builtin_amdgcn_mfma_f32_16x16x32_bf16(AFR, bfr[ni], acc[(MIX) < MI ? (MIX) : 0][ni], 0, 0, 0); \
            else acc[(MIX) < MI ? (MIX) : 0][ni] = __builtin_amdgcn_mfma_f32_16x16x32_bf16(bfr[ni], AFR, acc[(MIX) < MI ? (MIX) : 0][ni], 0, 0, 0); } }
#define G_PIECE(BUF, WOK, XP, XQ, GBASE, RS, GOFF, LOFF, I0) { \
        const int tp_ = opaque_tid_full(); \
        if (WOK) { unsigned char* d_ = smem + ((BUF) ^ 1) * 65536 + (LOFF) + swz(tp_ >> 3, tp_ & 7); \
            *(u32x4_ma*)(d_ + (I0) * 8192) = XP; *(u32x4_ma*)(d_ + ((I0) + 1) * 8192) = XQ; } \
        const unsigned go_ = (unsigned)((tp_ >> 3) * (GOFF) + (tp_ & 7) * 8) * 2u; \
        XP = *(const u32x4_ma*)((GBASE) + (size_t)(I0) * (RS) + go_); XQ = *(const u32x4_ma*)((GBASE) + (size_t)((I0) + 1) * (RS) + go_); }
#define G_PIECE1(BUF, WOK, XP, GBASE, RS, GOFF, LOFF, I0) { \
        const int tp_ = opaque_tid_full(); \
        if (WOK) { unsigned char* d_ = smem + ((BUF) ^ 1) * 65536 + (LOFF) + swz(tp_ >> 3, tp_ & 7); *(u32x4_ma*)(d_ + (I0) * 8192) = XP; } \
        const unsigned go_ = (unsigned)((tp_ >> 3) * (GOFF) + (tp_ & 7) * 8) * 2u; \
        XP = *(const u32x4_ma*)((GBASE) + (size_t)(I0) * (RS) + go_); }
#define G_KS(BUF, KX, HOOK1, HOOK2) { \
        const unsigned char* s_ = smem + (BUF) * 65536; \
        const int tk_ = opaque_tid_full(), lk_ = tk_ & 15, qk_ = (tk_ >> 4) & 3, ra_ = (tk_ >> 8) * WM + lk_, rb_ = ((tk_ >> 6) & 3) * WN + lk_; \
        const unsigned fa0_ = swz(ra_, qk_) ^ (KX), fa1_ = swz(ra_ + 16, qk_) ^ (KX), fb0_ = (32768u + swz(rb_, qk_)) ^ (KX), fb1_ = (32768u + swz(rb_ + 16, qk_)) ^ (KX); \
        bf16x8 bfr[NI]; \
        if (NI == 4) { _Pragma("unroll") for (int j = 0; j < 2; ++j) { \
            bfr[2 * j] = __builtin_bit_cast(bf16x8, *(const u32x4_ma*)(s_ + fb0_ + j * 4096)); \
            bfr[2 * j + 1] = __builtin_bit_cast(bf16x8, *(const u32x4_ma*)(s_ + fb1_ + j * 4096)); } } \
        else { _Pragma("unroll") for (int j = 0; j < NI; ++j) bfr[j] = __builtin_bit_cast(bf16x8, *(const u32x4_ma*)(s_ + ((32768u + swz(rb_ + 16 * j, qk_)) ^ (KX)))); } \
        bf16x8 afA = G_AF(0), afB = G_AF(1), afC = G_AF(2); \
        __builtin_amdgcn_s_setprio(1); \
        if (MI == 8) { \
            G_MM(0, afA); afA = G_AF(3); \
            G_MM(1, afB); afB = G_AF(4); __builtin_amdgcn_sched_barrier(0); \
            HOOK1; \
            G_MM(2, afC); afC = G_AF(5); \
            G_MM(3, afA); afA = G_AF(6); \
            G_MM(4, afB); afB = G_AF(7); \
            G_MM(5, afC); __builtin_amdgcn_sched_barrier(0); \
            HOOK2; \
            G_MM(6, afA); \
            G_MM(7, afB); \
        } else { \
            G_MM(0, afA); afA = G_AF(3); \
            G_MM(1, afB); __builtin_amdgcn_sched_barrier(0); \
            HOOK1; \
            G_MM(2, afC); __builtin_amdgcn_sched_barrier(0); \
            HOOK2; \
            G_MM(3, afA); } \
        __builtin_amdgcn_s_setprio(0); }
#define G_COMPUTE(BUF) { G_KS(BUF, 0u, ;, ;); G_KS(BUF, 64u, ;, ;); }
#define G_STEP(BUF, SIDX) { \
        if (EARLYW) { \
            const bool wok_ = (SIDX) + 1 < T; \
            const unsigned char* ga_ = (const unsigned char*)(A + (size_t)(ltm * 256 + hrow) * lda + lkt * 64); \
            const unsigned char* gb_ = (const unsigned char*)(B + (size_t)(ltn * NT) * ldb + lkt * 64); \
            G_KS(BUF, 0u, G_PIECE(BUF, wok_, xa0, xa1, ga_, ars, lda, 0, 0), if (MI == 8) G_PIECE(BUF, wok_, xa2, xa3, ga_, ars, lda, 0, 2)); \
            G_KS(BUF, 64u, G_PIECE(BUF, wok_, xb0, xb1, gb_, brs, ldb, 32768, 0), if (NI == 4) G_PIECE(BUF, wok_, xb2, xb3, gb_, brs, ldb, 32768, 2) else G_PIECE1(BUF, wok_, xb2, gb_, brs, ldb, 32768, 2)); \
            if (++lkt == nk) { lkt = 0; li += istep; if (li < lim) tile_at(nM, nN, li, ltm, ltn); } } \
        else { G_LOAD(); G_COMPUTE(BUF); if ((SIDX) + 1 < T) G_WRITE((BUF) ^ 1); } }

    G_LOAD();
    G_WRITE(0);
    if (EARLYW) G_LOAD();
    __syncthreads();
    for (int s = 0; s < T; s += 2) {
        G_STEP(0, s);
        __syncthreads();
        G_STEP(1, s + 1);
        ckt += 2;
        if (ckt == nk) {
            { const int m0 = ctm * 256 + hrow, n0 = ctn * NT;
              const int te = opaque_tid_full(), le = te & 63, l15 = le & 15, lq = le >> 4, wr = te >> 8, wc = (te >> 6) & 3;
    if (EPI == EPI_VT) {
#pragma unroll
        for (int mi = 0; mi < MI; ++mi)
#pragma unroll
            for (int ni = 0; ni < NI; ++ni) {
                const int m = m0 + wr * WM + mi * 16 + lq * 4, n = n0 + wc * WN + ni * 16 + l15;
                uint2 v; v.x = pack2(acc[mi][ni][0], acc[mi][ni][1]); v.y = pack2(acc[mi][ni][2], acc[mi][ni][3]);
                *(uint2*)(ep.obf + (size_t)n * ep.ldc + m) = v;
            }
    } else if (EPI == EPI_BF16) {
#pragma unroll
        for (int mi = 0; mi < MI; ++mi)
#pragma unroll
            for (int ni = 0; ni < NI; ++ni) {
                const int row = m0 + wr * WM + mi * 16 + l15, col = n0 + wc * WN + ni * 16 + lq * 4;
                if (col < ep.ncols) {
                    uint2 v; v.x = pack2(acc[mi][ni][0], acc[mi][ni][1]); v.y = pack2(acc[mi][ni][2], acc[mi][ni][3]);
                    *(uint2*)(ep.obf + (size_t)row * ep.ldc + col) = v;
                }
            }
    } else if (EPI == EPI_RESID) {
#pragma unroll
        for (int mi = 0; mi < MI; ++mi) {
            const int row = m0 + wr * WM + mi * 16 + l15;
            const float* src = row < 8192 ? ep.xs0 + (size_t)row * 1024 : ep.xs1 + (size_t)(row - 8192) * 1024;
            const int cond = row < 8192 ? 0 : 1 + ((row - 8192) >> 11);
            const float* g = ep.gate + cond * 6144;
            float* dst = ep.X + (size_t)row * 1024;
#pragma unroll
            for (int ni = 0; ni < NI; ++ni) {
                const int col = n0 + wc * WN + ni * 16 + lq * 4;
                const f32x4 xv = *(const f32x4*)(src + col);
                const f32x4 gv = *(const f32x4*)(g + col);
                f32x4 o = xv + gv * acc[mi][ni];
                *(f32x4*)(dst + col) = o;
            }
        }
    } else if (EPI == EPI_KHEAD) {
        const int h = (n0 >> 6) + wc;
        const float* kg = ep.gate;
        int ttype, tb = 0, tt0 = 0;
        if (m0 < 8192) ttype = 0;
        else { const int r2 = m0 - 8192; tb = r2 / 2304; tt0 = r2 - tb * 2304; ttype = tt0 < 2048 ? 1 : 2; }
#pragma unroll
        for (int mi = 0; mi < MI; ++mi) {
            const int rl = wr * WM + mi * 16 + l15;
            const int row = m0 + rl;
            float kp[8];
            if (ttype == 2) {
                const float* cs_ = ep.ckpe + ((size_t)((tb * 2 + ep.lyr) * 256 + (tt0 - 2048 + rl))) * 32 + lq * 8;
                const float4 c0 = *(const float4*)cs_, c1 = *(const float4*)(cs_ + 4);
                kp[0] = c0.x; kp[1] = c0.y; kp[2] = c0.z; kp[3] = c0.w; kp[4] = c1.x; kp[5] = c1.y; kp[6] = c1.z; kp[7] = c1.w;
            } else {
                const int msrc = ttype == 0 ? row : 8192 + tb * 2048 + tt0 + rl;
                const uint4 u = *(const uint4*)(ep.proj + (size_t)msrc * INC + 384 + lq * 8);
                kp[0] = bflo(u.x); kp[1] = bfhi(u.x); kp[2] = bflo(u.y); kp[3] = bfhi(u.y); kp[4] = bflo(u.z); kp[5] = bfhi(u.z); kp[6] = bflo(u.w); kp[7] = bfhi(u.w);
            }
            float ss = 0.f;
#pragma unroll
            for (int ni = 0; ni < NI; ++ni)
#pragma unroll
                for (int r = 0; r < 4; ++r) ss += acc[mi][ni][r] * acc[mi][ni][r];
#pragma unroll
            for (int j = 0; j < 8; ++j) ss += kp[j] * kp[j];
            ss += __shfl_xor(ss, 16); ss += __shfl_xor(ss, 32);
            const float rs = rsqrtf(ss * (1.f / 96.f) + EPS);
            bf16_t* dst = ep.obf + (size_t)row * 768 + h * 96;
#pragma unroll
            for (int ni = 0; ni < NI; ++ni) {
                const float4 gv = *(const float4*)(kg + ni * 16 + lq * 4);
                uint2 v; v.x = pack2(acc[mi][ni][0] * rs * gv.x, acc[mi][ni][1] * rs * gv.y); v.y = pack2(acc[mi][ni][2] * rs * gv.z, acc[mi][ni][3] * rs * gv.w);
                *(uint2*)(dst + ni * 16 + lq * 4) = v;
            }
            const float4 g0 = *(const float4*)(kg + 64 + lq * 8), g1 = *(const float4*)(kg + 64 + lq * 8 + 4);
            kp[0] *= rs * g0.x; kp[1] *= rs * g0.y; kp[2] *= rs * g0.z; kp[3] *= rs * g0.w; kp[4] *= rs * g1.x; kp[5] *= rs * g1.y; kp[6] *= rs * g1.z; kp[7] *= rs * g1.w;
            if (ttype == 1) {
                const int tt = tt0 + rl;
                const int pos = lq < 2 ? (tt >> 6) : (tt & 63);
#pragma unroll
                for (int j = 0; j < 8; ++j) {
                    const float pv = __shfl_xor(kp[j], 16);
                    float cs, sn; rope_cs(pos, j, cs, sn);
                    kp[j] = (lq & 1) ? (kp[j] * cs + pv * sn) : (kp[j] * cs - pv * sn);
                }
            }
            uint4 o; o.x = pack2(kp[0], kp[1]); o.y = pack2(kp[2], kp[3]); o.z = pack2(kp[4], kp[5]); o.w = pack2(kp[6], kp[7]);
            *(uint4*)(dst + 64 + lq * 8) = o;
            asm volatile("" ::: "memory");
        }
    } else {
#pragma unroll
        for (int mi = 0; mi < MI; ++mi) {
            const int row = m0 + wr * WM + mi * 16 + l15;
#pragma unroll
            for (int ni = 0; ni < 2; ++ni) {
                const int col = ((n0 + wc * 64) >> 1) + ni * 16 + lq * 4;
                float a[4];
#pragma unroll
                for (int r = 0; r < 4; ++r) { const float gv = acc[mi][ni][r], uv = acc[mi][ni + 2][r]; a[r] = gv / (1.f + __expf(-gv)) * uv; }
                uint2 v; v.x = pack2(a[0], a[1]); v.y = pack2(a[2], a[3]);
                *(uint2*)(ep.obf + (size_t)row * ep.ldc + col) = v;
            }
        }
    }
            }
            { float z = 0.f; asm volatile("" : "+v"(z));
#pragma unroll
              for (int i = 0; i < MI; ++i)
#pragma unroll
                for (int j = 0; j < NI; ++j) acc[i][j] = (f32x4){z, z, z, z}; }
            ckt = 0; ci += istep; if (ci < lim) tile_at(nM, nN, ci, ctm, ctn);
            asm volatile("s_waitcnt vmcnt(0)" ::: "memory");
        }
        __syncthreads();
    }
    asm volatile("s_waitcnt vmcnt(0)" ::: "memory");
#undef G_LOAD
#undef G_WRITE
#undef G_COMPUTE
#undef G_KS
#undef G_PIECE
#undef G_PIECE1
#undef G_AF
#undef G_MM
#undef G_STEP
}

__device__ __forceinline__ void mod_item(PP p, int it, unsigned char* smem) {
    const int l = it / 192, c0 = (it % 192) * 32;
    float* ssil = (float*)smem;
    float* red = ssil + 5 * 1024;
    const int t = opaque_tid();
    for (int idx = t; idx < 5 * 1024; idx += 256) {
        const int ci = idx >> 10, k = idx & 1023;
        const float v = ci == 0 ? p->in[6][k] : p->in[5][(ci - 1) * 1024 + k];
        ssil[idx] = v / (1.f + __expf(-v));
    }
    __syncthreads();
    const int kg = t >> 5, cj = t & 31;
    const float* wp = p->in[7] + (size_t)l * 1024 * 6144 + (size_t)(kg * 128) * 6144 + c0 + cj;
    float a0 = 0.f, a1 = 0.f, a2 = 0.f, a3 = 0.f, a4 = 0.f;
    int wstride = 6144; asm volatile("" : "+s"(wstride));
#pragma unroll 16
    for (int k = 0; k < 128; ++k) {
        const float wv = __builtin_nontemporal_load(wp + (size_t)(k * wstride));
        const int kk = kg * 128 + k;
        a0 += ssil[kk] * wv; a1 += ssil[1024 + kk] * wv; a2 += ssil[2048 + kk] * wv; a3 += ssil[3072 + kk] * wv; a4 += ssil[4096 + kk] * wv;
    }
    red[(kg * 5 + 0) * 32 + cj] = a0; red[(kg * 5 + 1) * 32 + cj] = a1; red[(kg * 5 + 2) * 32 + cj] = a2;
    red[(kg * 5 + 3) * 32 + cj] = a3; red[(kg * 5 + 4) * 32 + cj] = a4;
    __syncthreads();
    if (t < 160) {
        const int i = t >> 5, cc = t & 31;
        float s = p->in[8][l * 6144 + c0 + cc];
#pragma unroll
        for (int g = 0; g < 8; ++g) s += red[(g * 5 + i) * 32 + cc];
        ((float*)(p->ws + WS_MOD))[(l * 5 + i) * 6144 + c0 + cc] = s;
    }
    __syncthreads();
}

constexpr int CONV_ITEMS = 6001;
__device__ __forceinline__ void conv_item(PP p, int l, int it, unsigned char* smem) {
    const int t = opaque_tid();
    const float* W; int N, K, mat, idx; bf16_t* dst; const float* ksc = nullptr;
    if (it < 1104) { mat = 0; idx = it; W = p->in[11] + (size_t)l * 1024 * 2208; N = 2208; K = 1024; dst = (bf16_t*)(p->ws + WS_WIN); }
    else if (it < 1200) { mat = 1; idx = it - 1104; W = p->in[14] + (size_t)l * 256 * 768; N = 768; K = 256; dst = (bf16_t*)(p->ws + WS_WQUP); ksc = p->in[12] + l * 256; }
    else if (it < 1264) { mat = 2; idx = it - 1200; W = p->in[15] + (size_t)l * 128 * 1024; N = 1024; K = 128; dst = (bf16_t*)(p->ws + WS_WKV); }
    else if (it < 1776) { mat = 3; idx = it - 1264; W = p->in[21] + (size_t)l * 1024 * 1024; N = 1024; K = 1024; dst = (bf16_t*)(p->ws + WS_WO); }
    else if (it < 3184) { mat = 4; idx = it - 1776; W = p->in[22] + (size_t)l * 1024 * 2816; N = 2816; K = 1024; dst = (bf16_t*)(p->ws + WS_WGU); }
    else if (it < 4592) { mat = 5; idx = it - 3184; W = p->in[23] + (size_t)l * 1024 * 2816; N = 2816; K = 1024; dst = (bf16_t*)(p->ws + WS_WGU); }
    else if (it < 6000) { mat = 6; idx = it - 4592; W = p->in[24] + (size_t)l * 2816 * 1024; N = 1024; K = 2816; dst = (bf16_t*)(p->ws + WS_WDN); }
    else {
        uint4* z = (uint4*)(p->ws + WS_WIN + (size_t)2208 * 1024 * 2);
        unsigned zz = 0u; asm volatile("" : "+v"(zz));
        for (int i = t; i < 96 * 1024 * 2 / 16; i += 256) z[i] = make_uint4(zz, zz, zz, zz);
        return;
    }
    const int nNt = N >> 5;
    const int nt = idx % nNt, kt = idx / nNt;
    const int k0 = kt * 64 + (t >> 5) * 8, c = nt * 32 + (t & 31);
    const float* src = W + (size_t)k0 * N + c;
    float v[8];
#pragma unroll
    for (int j = 0; j < 8; ++j) v[j] = __builtin_nontemporal_load(src + (size_t)j * N);
    if (ksc) {
        const float4 s0 = *(const float4*)(ksc + k0), s1 = *(const float4*)(ksc + k0 + 4);
        v[0] *= s0.x; v[1] *= s0.y; v[2] *= s0.z; v[3] *= s0.w; v[4] *= s1.x; v[5] *= s1.y; v[6] *= s1.z; v[7] *= s1.w;
    }
    int orow;
    if (mat == 2) { const int h = c >> 7, j = c & 127; orow = j < 64 ? h * 64 + j : 512 + h * 64 + (j - 64); }
    else if (mat == 4) { orow = (c >> 5) * 64 + (c & 31); }
    else if (mat == 5) { orow = (c >> 5) * 64 + 32 + (c & 31); }
    else orow = c;
    uint4 o; o.x = pack2(v[0], v[1]); o.y = pack2(v[2], v[3]); o.z = pack2(v[4], v[5]); o.w = pack2(v[6], v[7]);
    *(uint4*)(dst + (size_t)orow * K + k0) = o;
}

__device__ __forceinline__ void norm_item(PP p, int l, int it, int which  ) {
    const int t = opaque_tid(), lane = t & 63, w = t >> 6;
    const int m0 = it * 8 + w * 2;
    const float* src0;
    if (which == 0 && l == 0) src0 = m0 < 8192 ? p->in[0] + (size_t)m0 * 1024 : p->in[1] + (size_t)(m0 - 8192) * 1024;
    else src0 = p->out + (size_t)m0 * 1024;
    float4 x[2][4];
#pragma unroll
    for (int r = 0; r < 2; ++r)
#pragma unroll
        for (int i = 0; i < 4; ++i) x[r][i] = *(const float4*)(src0 + r * 1024 + lane * 4 + 256 * i);
    const int cond = m0 < 8192 ? 0 : 1 + ((m0 - 8192) >> 11);
    const float* mod = (const float*)(p->ws + WS_MOD) + (l * 5 + cond) * 6144 + which * 3072;
    const float* g = (which == 0 ? p->in[9] : p->in[10]) + l * 1024;
    float ss0 = 0.f, ss1 = 0.f;
#pragma unroll
    for (int i = 0; i < 4; ++i) {
        ss0 += x[0][i].x * x[0][i].x + x[0][i].y * x[0][i].y + x[0][i].z * x[0][i].z + x[0][i].w * x[0][i].w;
        ss1 += x[1][i].x * x[1][i].x + x[1][i].y * x[1][i].y + x[1][i].z * x[1][i].z + x[1][i].w * x[1][i].w;
    }
#pragma unroll
    for (int o = 32; o; o >>= 1) { ss0 += __shfl_xor(ss0, o); ss1 += __shfl_xor(ss1, o); }
    const float rs0 = rsqrtf(ss0 * (1.f / 1024.f) + EPS), rs1 = rsqrtf(ss1 * (1.f / 1024.f) + EPS);
    bf16_t* dst = (bf16_t*)(p->ws + WS_HM) + (size_t)m0 * 1024;
#pragma unroll
    for (int i = 0; i < 4; ++i) {
        const int col = lane * 4 + 256 * i;
        const float4 gv = *(const float4*)(g + col), sh = *(const float4*)(mod + col), sc = *(const float4*)(mod + 1024 + col);
        const float a0 = gv.x * (1.f + sc.x), a1 = gv.y * (1.f + sc.y), a2 = gv.z * (1.f + sc.z), a3 = gv.w * (1.f + sc.w);
        uint2 o0, o1;
        o0.x = pack2(x[0][i].x * rs0 * a0 + sh.x, x[0][i].y * rs0 * a1 + sh.y); o0.y = pack2(x[0][i].z * rs0 * a2 + sh.z, x[0][i].w * rs0 * a3 + sh.w);
        o1.x = pack2(x[1][i].x * rs1 * a0 + sh.x, x[1][i].y * rs1 * a1 + sh.y); o1.y = pack2(x[1][i].z * rs1 * a2 + sh.z, x[1][i].w * rs1 * a3 + sh.w);
        *(uint2*)(dst + col) = o0;
        *(uint2*)(dst + 1024 + col) = o1;
    }
}

__device__ __forceinline__ float log_sigmoid(float x) { return -log1pf(expf(-x)); }

__device__ __forceinline__ void phaseC_item(PP p, int l, int it, unsigned char* smem) {
    const int c = it >> 2, hs = it & 3;
    const int t = opaque_tid(), lane = t & 63, w = t >> 6;
    const bf16_t* PROJ = (const bf16_t*)(p->ws + WS_PROJ);
    bf16_t* CKV = (bf16_t*)(p->ws + WS_CKV);
    bf16_t* MIX = (bf16_t*)(p->ws + WS_HM);
    float* MSQ = (float*)(p->ws + WS_MSQ);
    constexpr int UROW = 272, UKF = 0, UKB = 64 * UROW, UVT = 128 * UROW;
    {
        const float lgf = log_sigmoid(p->in[19][l * 4 + hs]), lgb = log_sigmoid(p->in[20][l * 4 + hs]);
#pragma unroll
        for (int i = 0; i < 4; ++i) {
            const int idx = t + 256 * i, a = idx >> 3, cc = (idx & 7) * 8;
            const bf16_t* pr = PROJ + (size_t)(c * 128 + a) * INC + hs * 64 + cc;
            const uint4 kv = *(const uint4*)(pr + 1440), vv = *(const uint4*)(pr + 1696);
            const float df = expf(lgf * (float)(127 - a)) * 0.125f, db = expf(lgb * (float)a) * 0.125f;
            const float kx[8] = {bflo(kv.x), bfhi(kv.x), bflo(kv.y), bfhi(kv.y), bflo(kv.z), bfhi(kv.z), bflo(kv.w), bfhi(kv.w)};
            const unsigned vw[4] = {vv.x, vv.y, vv.z, vv.w};
            bf16_t* kf = (bf16_t*)(smem + UKF) + a; bf16_t* kb = (bf16_t*)(smem + UKB) + a; bf16_t* vt = (bf16_t*)(smem + UVT) + a;
#pragma unroll
            for (int j = 0; j < 8; j += 2) {
                const unsigned pf = pack2(kx[j] * df, kx[j + 1] * df), pb = pack2(kx[j] * db, kx[j + 1] * db);
                kf[(cc + j) * (UROW / 2)] = (bf16_t)(pf & 0xffffu); kf[(cc + j + 1) * (UROW / 2)] = (bf16_t)(pf >> 16);
                kb[(cc + j) * (UROW / 2)] = (bf16_t)(pb & 0xffffu); kb[(cc + j + 1) * (UROW / 2)] = (bf16_t)(pb >> 16);
                vt[(cc + j) * (UROW / 2)] = (bf16_t)(vw[j >> 1] & 0xffffu); vt[(cc + j + 1) * (UROW / 2)] = (bf16_t)(vw[j >> 1] >> 16);
            }
        }
    }
    const float* kvg = p->in[13] + l * 128;
    const float* cw = p->in[18] + l * 768;
    for (int tt = 0; tt < 8; ++tt) {
        const int m = c * 128 + hs * 32 + w * 8 + tt;
        const bf16_t* pr = PROJ + (size_t)m * INC;
        const uint2 qv = *(const uint2*)(pr + lane * 4);
        const float q0 = bflo(qv.x), q1 = bfhi(qv.x), q2 = bflo(qv.y), q3 = bfhi(qv.y);
        const float ssq = wave_sum(q0 * q0 + q1 * q1 + q2 * q2 + q3 * q3);
        if (lane == 0) MSQ[m] = ssq * (1.f / 256.f) + EPS;
        const unsigned kvv = *(const unsigned*)(pr + 256 + lane * 2);
        const float k0 = bflo(kvv), k1 = bfhi(kvv);
        const float s2 = wave_sum(k0 * k0 + k1 * k1);
        const float rs = rsqrtf(s2 * (1.f / 128.f) + EPS);
        const float c0v = k0 * rs * kvg[lane * 2], c1v = k1 * rs * kvg[lane * 2 + 1];
        const bool ctx = m < 8192;
        const int kvrow = ctx ? m : m + ((m - 8192) >> 11) * 256;
        *(unsigned*)(CKV + (size_t)kvrow * 128 + lane * 2) = pack2(c0v, c1v);
        if (ctx) {
            const int b = m >> 8, tq = m & 255;
            const size_t orow = (size_t)((b * 2 + l) * 256 + tq);
            *(float2*)(p->out + OUT_CKV + orow * 128 + lane * 2) = make_float2(c0v, c1v);
            if (lane < 32) p->out[OUT_KPE + orow * 32 + lane] = bf2f(pr[384 + lane]);
        }
        const int tseq = ctx ? (m & 255) : ((m - 8192) & 2047);
        const int tlen = ctx ? 256 : 2048;
        const int ch = lane * 4;
        const uint2 gbv = *(const uint2*)(pr + 416 + ch);
        const uint2 gcv = *(const uint2*)(pr + 672 + ch), xv = *(const uint2*)(pr + 928 + ch);
        float uc[4] = {bflo(gcv.x) * bflo(xv.x), bfhi(gcv.x) * bfhi(xv.x), bflo(gcv.y) * bflo(xv.y), bfhi(gcv.y) * bfhi(xv.y)};
        float up[4] = {0.f, 0.f, 0.f, 0.f}, un[4] = {0.f, 0.f, 0.f, 0.f};
        if (tseq > 0) {
            const uint2 g2 = *(const uint2*)(pr - INC + 672 + ch), x2 = *(const uint2*)(pr - INC + 928 + ch);
            up[0] = bflo(g2.x) * bflo(x2.x); up[1] = bfhi(g2.x) * bfhi(x2.x); up[2] = bflo(g2.y) * bflo(x2.y); up[3] = bfhi(g2.y) * bfhi(x2.y);
        }
        if (tseq < tlen - 1) {
            const uint2 g2 = *(const uint2*)(pr + INC + 672 + ch), x2 = *(const uint2*)(pr + INC + 928 + ch);
            un[0] = bflo(g2.x) * bflo(x2.x); un[1] = bfhi(g2.x) * bfhi(x2.x); un[2] = bflo(g2.y) * bflo(x2.y); un[3] = bfhi(g2.y) * bfhi(x2.y);
        }
        const float4 w0 = *(const float4*)(cw + ch), w1 = *(const float4*)(cw + 256 + ch), w2 = *(const float4*)(cw + 512 + ch);
        const float y0 = bflo(gbv.x) * (w0.x * up[0] + w1.x * uc[0] + w2.x * un[0]);
        const float y1 = bfhi(gbv.x) * (w0.y * up[1] + w1.y * uc[1] + w2.y * un[1]);
        const float y2 = bflo(gbv.y) * (w0.z * up[2] + w1.z * uc[2] + w2.z * un[2]);
        const float y3 = bfhi(gbv.y) * (w0.w * up[3] + w1.w * uc[3] + w2.w * un[3]);
        uint2 o; o.x = pack2(y0, y1); o.y = pack2(y2, y3);
        *(uint2*)(MIX + (size_t)m * 1024 + 512 + ch) = o;
    }
    {
        const int j2 = it * 2 + (t >> 7), col = t & 127;
        const int b = j2 >> 8, j = j2 & 255;
        const float v = p->in[2][((size_t)((b * 2 + l) * 256 + j)) * 128 + col];
        CKV[(size_t)(8192 + b * 2304 + 2048 + j) * 128 + col] = (bf16_t)(pack2(v, v) & 0xffffu);
    }
    __syncthreads();
    {
        const int l15 = lane & 15, lq = lane >> 4;
        f32x4 uf[4], ub[4];
#pragma unroll
        for (int ni = 0; ni < 4; ++ni) { uf[ni] = (f32x4){0.f, 0.f, 0.f, 0.f}; ub[ni] = (f32x4){0.f, 0.f, 0.f, 0.f}; }
#pragma unroll
        for (int ks = 0; ks < 4; ++ks) {
            const unsigned ko = (ks * 32 + lq * 8) * 2;
            const bf16x8 af = *(const bf16x8*)(smem + UKF + (w * 16 + l15) * UROW + ko);
            const bf16x8 ab = *(const bf16x8*)(smem + UKB + (w * 16 + l15) * UROW + ko);
#pragma unroll
            for (int ni = 0; ni < 4; ++ni) {
                const bf16x8 vf = *(const bf16x8*)(smem + UVT + (ni * 16 + l15) * UROW + ko);
                uf[ni] = __builtin_amdgcn_mfma_f32_16x16x32_bf16(af, vf, uf[ni], 0, 0, 0);
                ub[ni] = __builtin_amdgcn_mfma_f32_16x16x32_bf16(ab, vf, ub[ni], 0, 0, 0);
            }
        }
        float* U = (float*)(p->ws + WS_U) + (size_t)((c * 4 + hs) * 2) * 4096;
#pragma unroll
        for (int ni = 0; ni < 4; ++ni)
#pragma unroll
            for (int r = 0; r < 4; ++r) {
                const int o = (w * 16 + lq * 4 + r) * 64 + ni * 16 + l15;
                U[o] = uf[ni][r]; U[4096 + o] = ub[ni][r];
            }
    }
    __syncthreads();
}

__device__ __forceinline__ void phaseE_item(PP p, int l, int it) {
    const int t = opaque_tid(), lane = t & 63, w = t >> 6;
    const int row = it * 4 + w;
    const int h = lane >> 3, pp = lane & 7;
    const bf16_t* PROJ = (const bf16_t*)(p->ws + WS_PROJ);
    const bf16_t* KRAW = (const bf16_t*)(p->ws + WS_KRAW);
    bf16_t* KB = (bf16_t*)(p->ws + WS_KB);
    float kp[4]; bool rope = false; int trow = 0, tcol = 0;
    int msrc = -1; size_t csrc = 0;
    if (row < 8192) msrc = row;
    else {
        const int r2 = row - 8192, b = r2 / 2304, tt = r2 - b * 2304;
        if (tt < 2048) { msrc = 8192 + b * 2048 + tt; rope = true; trow = tt >> 6; tcol = tt & 63; }
        else csrc = ((size_t)((b * 2 + l) * 256 + (tt - 2048))) * 32;
    }
    if (msrc >= 0) {
        const uint2 v = *(const uint2*)(PROJ + (size_t)msrc * INC + 384 + pp * 4);
        kp[0] = bflo(v.x); kp[1] = bfhi(v.x); kp[2] = bflo(v.y); kp[3] = bfhi(v.y);
    } else {
        const float4 v = *(const float4*)(p->in[3] + csrc + pp * 4);
        kp[0] = v.x; kp[1] = v.y; kp[2] = v.z; kp[3] = v.w;
    }
    const uint4 kn4 = *(const uint4*)(KRAW + (size_t)row * 512 + h * 64 + pp * 8);
    float kn[8] = {bflo(kn4.x), bfhi(kn4.x), bflo(kn4.y), bfhi(kn4.y), bflo(kn4.z), bfhi(kn4.z), bflo(kn4.w), bfhi(kn4.w)};
    float ss = 0.f;
#pragma unroll
    for (int j = 0; j < 8; ++j) ss += kn[j] * kn[j];
#pragma unroll
    for (int j = 0; j < 4; ++j) ss += kp[j] * kp[j];
    ss += __shfl_xor(ss, 1); ss += __shfl_xor(ss, 2); ss += __shfl_xor(ss, 4);
    const float rs = rsqrtf(ss * (1.f / 96.f) + EPS);
    const float* g = p->in[17] + l * 96;
#pragma unroll
    for (int j = 0; j < 8; ++j) kn[j] *= rs * g[pp * 8 + j];
#pragma unroll
    for (int j = 0; j < 4; ++j) kp[j] *= rs * g[64 + pp * 4 + j];
    float pv[4];
#pragma unroll
    for (int j = 0; j < 4; ++j) pv[j] = __shfl_xor(kp[j], 2);
    if (rope) {
        const int pos = pp < 4 ? trow : tcol;
#pragma unroll
        for (int j = 0; j < 4; ++j) {
            float cs, sn; rope_cs(pos, 4 * (pp & 1) + j, cs, sn);
            kp[j] = (pp & 2) ? (kp[j] * cs + pv[j] * sn) : (kp[j] * cs - pv[j] * sn);
        }
    }
    bf16_t* dst = KB + (size_t)row * 768 + h * 96;
    uint4 o; o.x = pack2(kn[0], kn[1]); o.y = pack2(kn[2], kn[3]); o.z = pack2(kn[4], kn[5]); o.w = pack2(kn[6], kn[7]);
    *(uint4*)(dst + pp * 8) = o;
    uint2 o2; o2.x = pack2(kp[0], kp[1]); o2.y = pack2(kp[2], kp[3]);
    *(uint2*)(dst + 64 + pp * 4) = o2;
}

constexpr int AT_KROW = 208, AT_VROW = 136, AT_VOFF = 64 * AT_KROW, AT_BUF = AT_VOFF + 64 * AT_VROW;
__device__ __forceinline__ void attn_item(PP p, int l, int ait, unsigned char* smem) {
    const int t = opaque_tid(), lane = t & 63, w = t >> 6, half = lane >> 5, ql = lane & 31;
    const bool lat = ait < 512;
    int b, h, qb, mq0, kv0, ntile;
    if (lat) { b = ait >> 7; h = (ait >> 4) & 7; qb = ait & 15; mq0 = 8192 + b * 2048 + qb * 128; kv0 = 8192 + b * 2304; ntile = 36; }
    else { const int i2 = ait - 512; b = i2 >> 4; h = (i2 >> 1) & 7; qb = i2 & 1; mq0 = b * 256 + qb * 128; kv0 = b * 256; ntile = 4; }
    const int m = mq0 + w * 32 + ql;
    const bf16_t* KBp = (const bf16_t*)(p->ws + WS_KB) + (size_t)kv0 * 768 + h * 96;
    const bf16_t* VTp = (const bf16_t*)(p->ws + WS_VT) + (size_t)(h * 64) * NKV + kv0;
    const int kr0 = t / 12, kc0 = t - kr0 * 12, kr1 = (t + 256) / 12, kc1 = (t + 256) - kr1 * 12, kr2 = (t + 512) / 12, kc2 = (t + 512) - kr2 * 12;
    const int vd0 = t >> 3, vd1 = (t + 256) >> 3, vc = t & 7;
    const unsigned kg0 = kr0 * 768 + kc0 * 8, kg1 = kr1 * 768 + kc1 * 8, kg2 = kr2 * 768 + kc2 * 8;
    const unsigned vg0 = vd0 * NKV + vc * 8, vg1 = vd1 * NKV + vc * 8;
    const unsigned kl0 = kr0 * AT_KROW + kc0 * 16, kl1 = kr1 * AT_KROW + kc1 * 16, kl2 = kr2 * AT_KROW + kc2 * 16;
    const unsigned vl0 = AT_VOFF + vd0 * AT_VROW + vc * 16, vl1 = AT_VOFF + vd1 * AT_VROW + vc * 16;
    bf16x8 qf[6];
    {
        const bf16_t* qsrc = (const bf16_t*)(p->ws + WS_QRAW) + (size_t)m * 768 + h * 96 + half * 8;
        float qv[6][8];
        float ss = 0.f;
#pragma unroll
        for (int ks = 0; ks < 6; ++ks) {
            const uint4 u = *(const uint4*)(qsrc + ks * 16);
            qv[ks][0] = bflo(u.x); qv[ks][1] = bfhi(u.x); qv[ks][2] = bflo(u.y); qv[ks][3] = bfhi(u.y);
            qv[ks][4] = bflo(u.z); qv[ks][5] = bfhi(u.z); qv[ks][6] = bflo(u.w); qv[ks][7] = bfhi(u.w);
#pragma unroll
            for (int j = 0; j < 8; ++j) ss += qv[ks][j] * qv[ks][j];
        }
        ss += __shfl_xor(ss, 32);
        const float msq = ((const float*)(p->ws + WS_MSQ))[m];
        const float rs = rsqrtf(ss * (1.f / 96.f) + EPS * msq);
        const float* qg = p->in[16] + l * 96 + half * 8;
#pragma unroll
        for (int ks = 0; ks < 6; ++ks)
#pragma unroll
            for (int j = 0; j < 8; ++j) qv[ks][j] *= rs * qg[ks * 16 + j];
        if (lat) {
            const int tt = qb * 128 + w * 32 + ql;
#pragma unroll
            for (int ks = 4; ks < 6; ++ks) {
                const int pos = ks == 4 ? (tt >> 6) : (tt & 63);
#pragma unroll
                for (int j = 0; j < 8; ++j) {
                    const float pv = __shfl_xor(qv[ks][j], 32);
                    float cs, sn; rope_cs(pos, j, cs, sn);
                    qv[ks][j] = half ? (qv[ks][j] * cs + pv * sn) : (qv[ks][j] * cs - pv * sn);
                }
            }
        }
        constexpr float QS = 0.10206207261596577f * 1.4426950408889634f;
#pragma unroll
        for (int ks = 0; ks < 6; ++ks)
            qf[ks] = mk8(pack2(qv[ks][0] * QS, qv[ks][1] * QS), pack2(qv[ks][2] * QS, qv[ks][3] * QS),
                         pack2(qv[ks][4] * QS, qv[ks][5] * QS), pack2(qv[ks][6] * QS, qv[ks][7] * QS));
    }
    uint4 r0k0, r0k1, r0k2, r0v0, r0v1, r1k0, r1k1, r1k2, r1v0, r1v1, r2k0, r2k1, r2k2, r2v0, r2v1;
#define A_LOAD(P, JT) { \
        const int jt_ = (JT) < ntile ? (JT) : ntile - 1; \
        const bf16_t* kp_ = KBp + (size_t)jt_ * (64 * 768); const bf16_t* vp_ = VTp + jt_ * 64; \
        P##k0 = *(const uint4*)(kp_ + kg0); P##k1 = *(const uint4*)(kp_ + kg1); P##k2 = *(const uint4*)(kp_ + kg2); \
        P##v0 = *(const uint4*)(vp_ + vg0); P##v1 = *(const uint4*)(vp_ + vg1); }
#define A_WRITE(P, STG) { \
        unsigned char* nb_ = smem + (STG) * AT_BUF; \
        *(uint4*)(nb_ + kl0) = P##k0; *(uint4*)(nb_ + kl1) = P##k1; *(uint4*)(nb_ + kl2) = P##k2; \
        *(uint2*)(nb_ + vl0) = make_uint2(P##v0.x, P##v0.y); *(uint2*)(nb_ + vl0 + 8) = make_uint2(P##v0.z, P##v0.w); \
        *(uint2*)(nb_ + vl1) = make_uint2(P##v1.x, P##v1.y); *(uint2*)(nb_ + vl1 + 8) = make_uint2(P##v1.z, P##v1.w); }
    A_LOAD(r0, 0);
    A_WRITE(r0, 0);
    A_LOAD(r1, 1);
    A_LOAD(r2, 2);
    __syncthreads();
    f32x16 o0, o1;
#pragma unroll
    for (int r = 0; r < 16; ++r) { o0[r] = 0.f; o1[r] = 0.f; }
    float mrun = -INFINITY, lrun = 0.f;
    const unsigned kfo = ql * AT_KROW + half * 16, vfo = AT_VOFF + ql * AT_VROW + half * 8;
#define A_COMPUTE(STG) { \
        const unsigned char* cur = smem + (STG) * AT_BUF; \
        f32x16 s0, s1; \
        _Pragma("unroll") for (int r = 0; r < 16; ++r) { s0[r] = 0.f; s1[r] = 0.f; } \
        _Pragma("unroll") for (int ks = 0; ks < 6; ++ks) { \
            const bf16x8 k0 = *(const bf16x8*)(cur + kfo + ks * 32); \
            const bf16x8 k1 = *(const bf16x8*)(cur + kfo + 32 * AT_KROW + ks * 32); \
            s0 = __builtin_amdgcn_mfma_f32_32x32x16_bf16(k0, qf[ks], s0, 0, 0, 0); \
            s1 = __builtin_amdgcn_mfma_f32_32x32x16_bf16(k1, qf[ks], s1, 0, 0, 0); } \
        float mx = fmaxf(s0[0], s1[0]); \
        _Pragma("unroll") for (int r = 1; r < 16; ++r) mx = fmaxf(mx, fmaxf(s0[r], s1[r])); \
        mx = fmaxf(mx, __shfl_xor(mx, 32)); \
        const float mnew = fmaxf(mrun, mx); \
        const float alpha = fexp2(mrun - mnew); \
        mrun = mnew; \
        float ls = 0.f; \
        _Pragma("unroll") for (int r = 0; r < 16; ++r) { s0[r] = fexp2(s0[r] - mnew); s1[r] = fexp2(s1[r] - mnew); ls += s0[r] + s1[r]; } \
        lrun = lrun * alpha + ls; \
        if (__any(alpha != 1.f)) { \
            _Pragma("unroll") for (int r = 0; r < 16; ++r) { o0[r] *= alpha; o1[r] *= alpha; } } \
        _Pragma("unroll") for (int s2 = 0; s2 < 4; ++s2) { \
            const int rb = 8 * (s2 & 1); \
            bf16x8 pf; \
            if (s2 < 2) pf = mk8(pack2(s0[rb + 0], s0[rb + 1]), pack2(s0[rb + 2], s0[rb + 3]), pack2(s0[rb + 4], s0[rb + 5]), pack2(s0[rb + 6], s0[rb + 7])); \
            else pf = mk8(pack2(s1[rb + 0], s1[rb + 1]), pack2(s1[rb + 2], s1[rb + 3]), pack2(s1[rb + 4], s1[rb + 5]), pack2(s1[rb + 6], s1[rb + 7])); \
            const unsigned char* va = cur + vfo + (16 * s2) * 2; \
            const uint2 a0 = *(const uint2*)va, a1 = *(const uint2*)(va + 16); \
            const uint2 b0 = *(const uint2*)(va + 32 * AT_VROW), b1 = *(const uint2*)(va + 32 * AT_VROW + 16); \
            o0 = __builtin_amdgcn_mfma_f32_32x32x16_bf16(mk8(a0.x, a0.y, a1.x, a1.y), pf, o0, 0, 0, 0); \
            o1 = __builtin_amdgcn_mfma_f32_32x32x16_bf16(mk8(b0.x, b0.y, b1.x, b1.y), pf, o1, 0, 0, 0); } }
    for (int j = 0; j < ntile; j += 3) {
        A_LOAD(r0, j + 3);
        A_COMPUTE(0);
        if (j + 1 < ntile) A_WRITE(r1, 1);
        __syncthreads();
        A_LOAD(r1, j + 4);
        if (j + 1 < ntile) A_COMPUTE(1);
        if (j + 2 < ntile) A_WRITE(r2, 2);
        __syncthreads();
        A_LOAD(r2, j + 5);
        if (j + 2 < ntile) A_COMPUTE(2);
        if (j + 3 < ntile) A_WRITE(r0, 0);
        __syncthreads();
    }
    asm volatile("s_waitcnt vmcnt(0)" ::: "memory");
#undef A_LOAD
#undef A_WRITE
#undef A_COMPUTE
    const float ltot = lrun + __shfl_xor(lrun, 32);
    const float inv = 1.f / ltot;
    bf16_t* dst = (bf16_t*)(p->ws + WS_HM) + (size_t)m * 1024 + h * 64;
#pragma unroll
    for (int g = 0; g < 4; ++g) {
        uint2 v; v.x = pack2(o0[4 * g] * inv, o0[4 * g + 1] * inv); v.y = pack2(o0[4 * g + 2] * inv, o0[4 * g + 3] * inv);
        *(uint2*)(dst + 8 * g + 4 * half) = v;
        uint2 u; u.x = pack2(o1[4 * g] * inv, o1[4 * g + 1] * inv); u.y = pack2(o1[4 * g + 2] * inv, o1[4 * g + 3] * inv);
        *(uint2*)(dst + 32 + 8 * g + 4 * half) = u;
    }
}

constexpr int RT_KROW = 144, RT_VROW = 264, RT_SROW = 144;
constexpr int RT_KOFF = 0, RT_VOFF = 128 * RT_KROW, RT_SFOFF = RT_VOFF + 64 * RT_VROW, RT_SBOFF = RT_SFOFF + 64 * RT_SROW;
__device__ __forceinline__ void ret_item(PP p, int l, int rit, unsigned char* smem) {
    const int c = rit >> 2, h = rit & 3;
    const int t = opaque_tid(), lane = t & 63, w = t >> 6, half = lane >> 5, ql = lane & 31;
    const bool ctx = c < 64;
    int b, ci, n, cbase;
    if (ctx) { b = c >> 1; ci = c & 1; n = 2; cbase = c - ci; }
    else { const int c2 = c - 64; b = c2 >> 4; ci = c2 & 15; n = 16; cbase = c - ci; }
    const bf16_t* PROJ = (const bf16_t*)(p->ws + WS_PROJ);
    const float lgf = log_sigmoid(p->in[19][l * 4 + h]), lgb = log_sigmoid(p->in[20][l * 4 + h]);
    const float cf = expf(lgf * 128.f), cb = expf(lgb * 128.f);
    const float lgf2 = lgf * 1.4426950408889634f, lgb2 = lgb * 1.4426950408889634f;
#pragma unroll
    for (int i = 0; i < 4; ++i) {
        const int idx = t + 256 * i, a = idx >> 3, cc = idx & 7;
        const bf16_t* pr = PROJ + (size_t)(c * 128 + a) * INC + h * 64 + cc * 8;
        const uint4 kv = *(const uint4*)(pr + 1440), vv = *(const uint4*)(pr + 1696);
        *(uint4*)(smem + RT_KOFF + a * RT_KROW + cc * 16) = kv;
        bf16_t* vt = (bf16_t*)(smem + RT_VOFF) + a;
        const int d0 = cc * 8;
        vt[(d0 + 0) * (RT_VROW / 2)] = (bf16_t)(vv.x & 0xffffu); vt[(d0 + 1) * (RT_VROW / 2)] = (bf16_t)(vv.x >> 16);
        vt[(d0 + 2) * (RT_VROW / 2)] = (bf16_t)(vv.y & 0xffffu); vt[(d0 + 3) * (RT_VROW / 2)] = (bf16_t)(vv.y >> 16);
        vt[(d0 + 4) * (RT_VROW / 2)] = (bf16_t)(vv.z & 0xffffu); vt[(d0 + 5) * (RT_VROW / 2)] = (bf16_t)(vv.z >> 16);
        vt[(d0 + 6) * (RT_VROW / 2)] = (bf16_t)(vv.w & 0xffffu); vt[(d0 + 7) * (RT_VROW / 2)] = (bf16_t)(vv.w >> 16);
    }
    {
        const int e0 = t * 16, dk = e0 >> 6, dv0 = e0 & 63;
        const float* U = (const float*)(p->ws + WS_U);
        float sf[16], sb[16];
        if (ctx) {
#pragma unroll
            for (int j = 0; j < 16; ++j) { sf[j] = 0.f; sb[j] = 0.f; }
        } else {
            const float* s0f = p->in[4] + ((size_t)(((b * 2 + l) * 2 + 0) * 4 + h)) * 4096 + e0;
            const float* s0b = p->in[4] + ((size_t)(((b * 2 + l) * 2 + 1) * 4 + h)) * 4096 + e0;
#pragma unroll
            for (int j = 0; j < 16; j += 4) {
                const float4 a = *(const float4*)(s0f + j), bb = *(const float4*)(s0b + j);
                sf[j] = a.x; sf[j + 1] = a.y; sf[j + 2] = a.z; sf[j + 3] = a.w;
                sb[j] = bb.x; sb[j + 1] = bb.y; sb[j + 2] = bb.z; sb[j + 3] = bb.w;
            }
        }
        for (int jb = 0; jb < ci; jb += 4) {
            float4 ua[4][4];
#pragma unroll
            for (int k = 0; k < 4; ++k) {
                const int jj = jb + k < ci ? jb + k : ci - 1;
                const float* u = U + (size_t)(((cbase + jj) * 4 + h) * 2 + 0) * 4096 + e0;
#pragma unroll
                for (int q = 0; q < 4; ++q) ua[k][q] = *(const float4*)(u + 4 * q);
            }
#pragma unroll
            for (int k = 0; k < 4; ++k)
                if (jb + k < ci) {
#pragma unroll
                    for (int q = 0; q < 4; ++q) { sf[4 * q] = cf * sf[4 * q] + ua[k][q].x; sf[4 * q + 1] = cf * sf[4 * q + 1] + ua[k][q].y; sf[4 * q + 2] = cf * sf[4 * q + 2] + ua[k][q].z; sf[4 * q + 3] = cf * sf[4 * q + 3] + ua[k][q].w; }
                }
        }
        {
            const int cnt = n - 1 - ci;
            for (int jb = 0; jb < cnt; jb += 4) {
                float4 ua[4][4];
#pragma unroll
                for (int k = 0; k < 4; ++k) {
                    const int jj = jb + k < cnt ? n - 1 - (jb + k) : ci + 1;
                    const float* u = U + (size_t)(((cbase + jj) * 4 + h) * 2 + 1) * 4096 + e0;
#pragma unroll
                    for (int q = 0; q < 4; ++q) ua[k][q] = *(const float4*)(u + 4 * q);
                }
#pragma unroll
                for (int k = 0; k < 4; ++k)
                    if (jb + k < cnt) {
#pragma unroll
                        for (int q = 0; q < 4; ++q) { sb[4 * q] = cb * sb[4 * q] + ua[k][q].x; sb[4 * q + 1] = cb * sb[4 * q + 1] + ua[k][q].y; sb[4 * q + 2] = cb * sb[4 * q + 2] + ua[k][q].z; sb[4 * q + 3] = cb * sb[4 * q + 3] + ua[k][q].w; }
                    }
            }
        }
        if (ctx) {
            if (ci == n - 1) {
                const float* u = U + (size_t)((c * 4 + h) * 2 + 0) * 4096 + e0;
                float* o = p->out + OUT_ST + ((size_t)(((b * 2 + l) * 2 + 0) * 4 + h)) * 4096 + e0;
#pragma unroll
                for (int j = 0; j < 16; j += 4) { const float4 a = *(const float4*)(u + j); *(float4*)(o + j) = make_float4(cf * sf[j] + a.x, cf * sf[j + 1] + a.y, cf * sf[j + 2] + a.z, cf * sf[j + 3] + a.w); }
            }
            if (ci == 0) {
                const float* u = U + (size_t)((c * 4 + h) * 2 + 1) * 4096 + e0;
                float* o = p->out + OUT_ST + ((size_t)(((b * 2 + l) * 2 + 1) * 4 + h)) * 4096 + e0;
#pragma unroll
                for (int j = 0; j < 16; j += 4) { const float4 a = *(const float4*)(u + j); *(float4*)(o + j) = make_float4(cb * sb[j] + a.x, cb * sb[j + 1] + a.y, cb * sb[j + 2] + a.z, cb * sb[j + 3] + a.w); }
            }
        }
        bf16_t* sF = (bf16_t*)(smem + RT_SFOFF) + dk; bf16_t* sB = (bf16_t*)(smem + RT_SBOFF) + dk;
#pragma unroll
        for (int j = 0; j < 16; j += 2) {
            const unsigned pf = pack2(sf[j], sf[j + 1]), pb = pack2(sb[j], sb[j + 1]);
            sF[(dv0 + j) * (RT_SROW / 2)] = (bf16_t)(pf & 0xffffu); sF[(dv0 + j + 1) * (RT_SROW / 2)] = (bf16_t)(pf >> 16);
            sB[(dv0 + j) * (RT_SROW / 2)] = (bf16_t)(pb & 0xffffu); sB[(dv0 + j + 1) * (RT_SROW / 2)] = (bf16_t)(pb >> 16);
        }
    }
    const int a = w * 32 + ql;
    const int m = c * 128 + a;
    bf16x8 qf[4];
    {
        const bf16_t* qsrc = PROJ + (size_t)m * INC + 1184 + h * 64 + half * 8;
#pragma unroll
        for (int ks = 0; ks < 4; ++ks) { const uint4 u = *(const uint4*)(qsrc + ks * 16); qf[ks] = mk8(u.x, u.y, u.z, u.w); }
    }
    __syncthreads();
    f32x16 o0, o1;
    {
        f32x16 f0, f1;
#pragma unroll
        for (int r = 0; r < 16; ++r) { f0[r] = 0.f; f1[r] = 0.f; }
#pragma unroll
        for (int ks = 0; ks < 4; ++ks) {
            const int ko = (ks * 16 + half * 8) * 2;
            const bf16x8 sf0 = *(const bf16x8*)(smem + RT_SFOFF + ql * RT_SROW + ko), sf1 = *(const bf16x8*)(smem + RT_SFOFF + (32 + ql) * RT_SROW + ko);
            f0 = __builtin_amdgcn_mfma_f32_32x32x16_bf16(sf0, qf[ks], f0, 0, 0, 0);
            f1 = __builtin_amdgcn_mfma_f32_32x32x16_bf16(sf1, qf[ks], f1, 0, 0, 0);
        }
        const float wf = fexp2(lgf2 * (float)(a + 1));
#pragma unroll
        for (int r = 0; r < 16; ++r) { o0[r] = wf * f0[r]; o1[r] = wf * f1[r]; }
#pragma unroll
        for (int r = 0; r < 16; ++r) { f0[r] = 0.f; f1[r] = 0.f; }
#pragma unroll
        for (int ks = 0; ks < 4; ++ks) {
            const int ko = (ks * 16 + half * 8) * 2;
            const bf16x8 sb0 = *(const bf16x8*)(smem + RT_SBOFF + ql * RT_SROW + ko), sb1 = *(const bf16x8*)(smem + RT_SBOFF + (32 + ql) * RT_SROW + ko);
            f0 = __builtin_amdgcn_mfma_f32_32x32x16_bf16(sb0, qf[ks], f0, 0, 0, 0);
            f1 = __builtin_amdgcn_mfma_f32_32x32x16_bf16(sb1, qf[ks], f1, 0, 0, 0);
        }
        const float wb = fexp2(lgb2 * (float)(128 - a));
#pragma unroll
        for (int r = 0; r < 16; ++r) { o0[r] += wb * f0[r]; o1[r] += wb * f1[r]; }
    }
#pragma unroll 1
    for (int kt2 = 0; kt2 < 4; ++kt2) {
        f32x16 s;
#pragma unroll
        for (int r = 0; r < 16; ++r) s[r] = 0.f;
#pragma unroll
        for (int ks = 0; ks < 4; ++ks) {
            const bf16x8 kf = *(const bf16x8*)(smem + RT_KOFF + (kt2 * 32 + ql) * RT_KROW + (ks * 16 + half * 8) * 2);
            s = __builtin_amdgcn_mfma_f32_32x32x16_bf16(kf, qf[ks], s, 0, 0, 0);
        }
#pragma unroll
        for (int r = 0; r < 16; ++r) {
            const int ap = kt2 * 32 + (r & 3) + 8 * (r >> 2) + 4 * half;
            const int d = a - ap;
            const float dec = d > 0 ? fexp2(lgf2 * (float)d) : (d < 0 ? fexp2(lgb2 * (float)(-d)) : 2.f);
            s[r] = s[r] * dec * 0.125f;
        }
#pragma unroll
        for (int s2 = 0; s2 < 2; ++s2) {
            const int rb = 8 * s2;
            const bf16x8 pf = mk8(pack2(s[rb + 0], s[rb + 1]), pack2(s[rb + 2], s[rb + 3]), pack2(s[rb + 4], s[rb + 5]), pack2(s[rb + 6], s[rb + 7]));
            const int keyb = kt2 * 32 + 16 * s2 + 4 * half;
            const unsigned char* va = smem + RT_VOFF + ql * RT_VROW + keyb * 2;
            const uint2 a0 = *(const uint2*)va, a1 = *(const uint2*)(va + 16);
            const uint2 b0 = *(const uint2*)(va + 32 * RT_VROW), b1 = *(const uint2*)(va + 32 * RT_VROW + 16);
            o0 = __builtin_amdgcn_mfma_f32_32x32x16_bf16(mk8(a0.x, a0.y, a1.x, a1.y), pf, o0, 0, 0, 0);
            o1 = __builtin_amdgcn_mfma_f32_32x32x16_bf16(mk8(b0.x, b0.y, b1.x, b1.y), pf, o1, 0, 0, 0);
        }
    }
    float ss = 0.f;
#pragma unroll
    for (int r = 0; r < 16; ++r) ss += o0[r] * o0[r] + o1[r] * o1[r];
    ss += __shfl_xor(ss, 32);
    const float rs = rsqrtf(ss * (1.f / 64.f) + EPS);
    const bf16_t* rg = PROJ + (size_t)m * INC + 1952 + h * 64;
    bf16_t* dst = (bf16_t*)(p->ws + WS_HM) + (size_t)m * 1024 + 768 + h * 64;
#pragma unroll
    for (int g = 0; g < 4; ++g) {
#pragma unroll
        for (int dt = 0; dt < 2; ++dt) {
            const int dv = dt * 32 + 8 * g + 4 * half;
            const uint2 gv = *(const uint2*)(rg + dv);
            const float g0 = bflo(gv.x), g1 = bfhi(gv.x), g2 = bflo(gv.y), g3 = bfhi(gv.y);
            const float x0 = dt ? o1[4 * g] : o0[4 * g], x1 = dt ? o1[4 * g + 1] : o0[4 * g + 1], x2 = dt ? o1[4 * g + 2] : o0[4 * g + 2], x3 = dt ? o1[4 * g + 3] : o0[4 * g + 3];
            uint2 v;
            v.x = pack2(x0 * rs * (g0 / (1.f + __expf(-g0))), x1 * rs * (g1 / (1.f + __expf(-g1))));
            v.y = pack2(x2 * rs * (g2 / (1.f + __expf(-g2))), x3 * rs * (g3 / (1.f + __expf(-g3))));
            *(uint2*)(dst + dv) = v;
        }
    }
    __syncthreads();
}

constexpr int NPHASE = 19;
__device__ __forceinline__ void run_phase(PP p, int ph, unsigned char* smem) {
    const int vb = opaque_tid_full() >> 8;
    const int G = 2 * gridDim.x, bid = 2 * opaque_bid() + vb;
    unsigned char* vsm = smem + vb * VSMEM;
    if (ph == 0) {
        if (bid < 384) mod_item(p, bid, vsm);
        else { for (int j = 0; j < 10; ++j) conv_item(p, 0, (bid - 384) * 10 + j, vsm); }
        for (int it = 1280 + bid; it < CONV_ITEMS; it += G) conv_item(p, 0, it, vsm);
        return;
    }
    const int l = (ph - 1) / 9, s = (ph - 1) % 9;
    float* MOD = (float*)(p->ws + WS_MOD);
    bf16_t* HM = (bf16_t*)(p->ws + WS_HM);
    Epi ep; ep.obf = nullptr; ep.ldc = 0; ep.ncols = 0; ep.X = p->out; ep.xs0 = p->out; ep.xs1 = p->out + (size_t)8192 * 1024; ep.gate = MOD; ep.proj = nullptr; ep.ckpe = nullptr; ep.lyr = l;
    switch (s) {
    case 0: {
        const int nconv = l == 0 ? 0 : CONV_ITEMS;
        for (int it = bid; it < 2048 + nconv; it += G) {
            if (it < 2048) norm_item(p, l, it, 0); else conv_item(p, l, it - 2048, vsm);
        }
    } break;
    case 1: {
        ep.obf = (bf16_t*)(p->ws + WS_PROJ); ep.ldc = INC; ep.ncols = INC;
        gemm_phase<EPI_BF16, true, 3>(HM, 1024, (const bf16_t*)(p->ws + WS_WIN), 1024, NTOK, 2304, 1024, ep, smem);
    } break;
    case 2: {
        for (int it = bid; it < 512; it += G) phaseC_item(p, l, it, vsm);
    } break;
    case 3: {
        ep.obf = (bf16_t*)(p->ws + WS_QRAW); ep.ldc = 768; ep.ncols = 768;
        gemm_phase<EPI_BF16, false>((const bf16_t*)(p->ws + WS_PROJ), INC, (const bf16_t*)(p->ws + WS_WQUP), 256, NTOK, 768, 256, ep, smem);
        ep.obf = (bf16_t*)(p->ws + WS_KB); ep.gate = p->in[17] + l * 96; ep.proj = (const bf16_t*)(p->ws + WS_PROJ); ep.ckpe = p->in[3]; ep.lyr = l;
        gemm_phase<EPI_KHEAD, false>((const bf16_t*)(p->ws + WS_CKV), 128, (const bf16_t*)(p->ws + WS_WKV), 128, NKV, 512, 128, ep, smem, 0, 8);
        ep.obf = (bf16_t*)(p->ws + WS_VT); ep.ldc = NKV; ep.ncols = 512;
        gemm_phase<EPI_VT, false>((const bf16_t*)(p->ws + WS_CKV), 128, (const bf16_t*)(p->ws + WS_WKV) + (size_t)512 * 128, 128, NKV, 512, 128, ep, smem, 0, 22);
    } break;
    case 4: {
        for (int it = bid; it < 1536; it += G) {
            if (it >= 512 && it < 1024) ret_item(p, l, it - 512, vsm);
            else attn_item(p, l, it < 512 ? it : it - 512, vsm);
        }
    } break;
    case 5: {
        if (l == 0) { ep.xs0 = p->in[0]; ep.xs1 = p->in[1]; }
        ep.gate = MOD + l * 5 * 6144 + 2 * 1024;
        gemm_phase<EPI_RESID>(HM, 1024, (const bf16_t*)(p->ws + WS_WO), 1024, NTOK, 1024, 1024, ep, smem);
    } break;
    case 6: {
        for (int it = bid; it < 2048; it += G) norm_item(p, l, it, 1);
    } break;
    case 7: {
        ep.obf = (bf16_t*)(p->ws + WS_ACT); ep.ldc = FFH; ep.ncols = FFH;
        gemm_phase<EPI_SWIGLU, true, 4, 8>(HM, 1024, (const bf16_t*)(p->ws + WS_WGU), 1024, NTOK, 5632, 1024, ep, smem, 1);
        gemm_phase<EPI_SWIGLU, true, 4, 4>(HM, 1024, (const bf16_t*)(p->ws + WS_WGU), 1024, NTOK, 5632, 1024, ep, smem, 2);
    } break;
    case 8: {
        ep.gate = MOD + l * 5 * 6144 + 5 * 1024;
        gemm_phase<EPI_RESID>((const bf16_t*)(p->ws + WS_ACT), FFH, (const bf16_t*)(p->ws + WS_WDN), FFH, NTOK, 1024, FFH, ep, smem);
    } break;
    }
}

__global__ void __launch_bounds__(512, 2) mk_forward(Params p_arg, int ph_lo, int ph_hi) {
    __shared__ __attribute__((aligned(16))) unsigned char smem[SMEM_BYTES];
    PP p = (PP)__builtin_amdgcn_kernarg_segment_ptr();
    volatile LAS unsigned* st = (volatile LAS unsigned*)(smem + SMEM_BYTES - 16);
    const bool multi = (ph_hi - ph_lo) > 1;
    if (multi) {
        if (opaque_tid_full() == 0) { st[0] = 0u; st[1] = 0u; st[2] = 0u; st[3] = 0u; }
        __syncthreads();
        (void)xcd_barrier_post((unsigned*)(p->ws + WS_BAR), st);
    }
#define MK_PH(N) \
    if ((N) >= ph_lo && (N) < ph_hi) { \
        if ((N) > ph_lo) { \
            if (ph_lo > 4096) { __syncthreads(); cg::this_grid().sync(); }     \
            asm volatile("" : "+s"(p)); \
            XcdBarrier xb; xb.bar = (unsigned*)(p->ws + WS_BAR); xb.x = xb_xcc_id(); xb.st = st; \
            xcd_barrier(xb); \
        } \
        asm volatile("" : "+s"(p)); \
        run_phase(p, (N), smem); \
    }
    MK_PH(0) MK_PH(1) MK_PH(2) MK_PH(3) MK_PH(4) MK_PH(5) MK_PH(6) MK_PH(7) MK_PH(8) MK_PH(9)
    MK_PH(10) MK_PH(11) MK_PH(12) MK_PH(13) MK_PH(14) MK_PH(15) MK_PH(16) MK_PH(17) MK_PH(18)
#undef MK_PH
}

extern "C" void kernel_launch(void* const* d_in, const int* in_sizes, int n_in, void* d_out, int out_size, void* d_ws, size_t ws_size, hipStream_t stream) {
    Params p{};
    for (int i = 0; i < 25; ++i) p.in[i] = (const float*)d_in[i];
    p.out = (float*)d_out;
    p.ws = (unsigned char*)d_ws;
    static int grid_blocks = 0;
    if (!grid_blocks) {
        int dev = 0, cus = 0, per_cu = 0;
        hipGetDevice(&dev);
        hipDeviceGetAttribute(&cus, hipDeviceAttributeMultiprocessorCount, dev);
        hipOccupancyMaxActiveBlocksPerMultiprocessor(&per_cu, mk_forward, 512, 0);
        if (per_cu > 1) per_cu = 1;
        if (per_cu < 1) per_cu = 1;
        grid_blocks = cus * per_cu;
    }
    hipMemsetAsync((unsigned char*)d_ws + WS_BAR, 0, 16384, stream);
#if MK_MULTI
    for (int ph = 0; ph < NPHASE; ++ph) hipLaunchKernelGGL(mk_forward, dim3(grid_blocks), dim3(512), 0, stream, p, ph, ph + 1);
#else
    int lo = 0, hi = NPHASE;
    void* args[] = {&p, &lo, &hi};
    hipError_t e = hipLaunchCooperativeKernel((const void*)mk_forward, dim3(grid_blocks), dim3(512), args, 0, stream);
    if (e != hipSuccess) fprintf(stderr, "cooperative launch failed: %s (grid %d)\n", hipGetErrorString(e), grid_blocks);
#endif
}
```

```cpp
#include <hip/hip_runtime.h>
#include <hip/hip_cooperative_groups.h>
#include <stdint.h>
#include <cstdio>
namespace cg = cooperative_groups;

#ifndef MK_MULTI
#define MK_MULTI 0
#endif

typedef unsigned short bf16_t;
typedef short bf16x8 __attribute__((ext_vector_type(8)));
typedef float f32x4 __attribute__((ext_vector_type(4)));
typedef float f32x16 __attribute__((ext_vector_type(16)));
typedef unsigned u32x4 __attribute__((ext_vector_type(4)));
typedef u32x4 __attribute__((may_alias)) u32x4_ma;

constexpr int NTOK = 16384;
constexpr int NKV = 17408;
constexpr int INC = 2208;
constexpr int FFH = 2816;
constexpr float EPS = 1e-6f;

constexpr size_t OUT_CKV = 16777216, OUT_KPE = 18874368, OUT_ST = 19398656;

constexpr size_t WS_BAR = 0;
constexpr size_t WS_MOD = 16384;
constexpr size_t WS_MSQ = WS_MOD + 2 * 5 * 6144 * 4;
constexpr size_t WS_WIN = WS_MSQ + NTOK * 4;
constexpr size_t WS_WQUP = WS_WIN + (size_t)2304 * 1024 * 2;
constexpr size_t WS_WKV = WS_WQUP + (size_t)768 * 256 * 2;
constexpr size_t WS_WO = WS_WKV + (size_t)1024 * 128 * 2;
constexpr size_t WS_WGU = WS_WO + (size_t)1024 * 1024 * 2;
constexpr size_t WS_WDN = WS_WGU + (size_t)5632 * 1024 * 2;
constexpr size_t WS_HM = WS_WDN + (size_t)1024 * 2816 * 2;
constexpr size_t WS_PROJ = WS_HM + (size_t)NTOK * 1024 * 2;
constexpr size_t WS_CKV = WS_PROJ + (size_t)NTOK * INC * 2;
constexpr size_t WS_QRAW = WS_CKV + (size_t)NKV * 128 * 2;
constexpr size_t WS_KRAW = WS_QRAW + (size_t)NTOK * 768 * 2;
constexpr size_t WS_KB = WS_KRAW + (size_t)NKV * 512 * 2;
constexpr size_t WS_VT = WS_KB + (size_t)NKV * 768 * 2;
constexpr size_t WS_U = WS_VT + (size_t)512 * NKV * 2;
constexpr size_t WS_END = WS_U + (size_t)128 * 4 * 2 * 4096 * 4;
constexpr size_t WS_ACT = WS_PROJ;
static_assert((size_t)NTOK * FFH * 2 <= WS_KRAW - WS_PROJ, "ACT overlay");
static_assert(WS_END <= (size_t)256 * 1024 * 1024, "workspace");

constexpr int VSMEM = 67584;
constexpr int SMEM_BYTES = 2 * VSMEM;

struct Params {
    const float* in[25];
    float* out;
    unsigned char* ws;
};
typedef const Params __attribute__((address_space(4)))* PP;

__device__ __forceinline__ float bflo(unsigned u) { return __uint_as_float(u << 16); }
__device__ __forceinline__ float bfhi(unsigned u) { return __uint_as_float(u & 0xffff0000u); }
__device__ __forceinline__ float bf2f(bf16_t b) { return __uint_as_float(((unsigned)b) << 16); }
__device__ __forceinline__ unsigned pack2(float lo, float hi) { unsigned r; asm("v_cvt_pk_bf16_f32 %0, %1, %2" : "=v"(r) : "v"(lo), "v"(hi)); return r; }
__device__ __forceinline__ bf16x8 mk8(unsigned a, unsigned b, unsigned c, unsigned d) { u32x4 v = {a, b, c, d}; return __builtin_bit_cast(bf16x8, v); }
__device__ __forceinline__ float wave_sum(float v) {
#pragma unroll
    for (int o = 32; o; o >>= 1) v += __shfl_xor(v, o);
    return v;
}
__device__ __forceinline__ float fexp2(float x) { return __builtin_amdgcn_exp2f(x); }
__device__ __forceinline__ int opaque_bid() { int b = blockIdx.x; asm volatile("" : "+s"(b)); return b; }
__device__ __forceinline__ int opaque_tid() { int t = threadIdx.x; asm volatile("" : "+v"(t)); return t & 255; }
__device__ __forceinline__ int opaque_tid_full() { int t = threadIdx.x; asm volatile("" : "+v"(t)); return t; }

#define XB_TMO      128
#define XB_XCNT(j)  (256  + 64 * (j))
#define XB_XSUB(j)  (1280 + 64 * (j))
#define XB_XGEN(j)  (2304 + 64 * (j))
#define XB_TOP      3328
#define XB_TOPGEN   3392
#define XCD_BAR_WORDS 3456
#define XB_SPIN_CAP (1u << 22)
#define LAS __attribute__((address_space(3)))
__device__ __forceinline__ unsigned xb_ld(unsigned* p)              { return __hip_atomic_load(p, __ATOMIC_RELAXED, __HIP_MEMORY_SCOPE_AGENT); }
__device__ __forceinline__ unsigned xb_add(unsigned* p, unsigned v) { return __hip_atomic_fetch_add(p, v, __ATOMIC_RELAXED, __HIP_MEMORY_SCOPE_AGENT); }
__device__ __forceinline__ unsigned xb_xcc_id() { return (unsigned)__builtin_amdgcn_s_getreg((3 << 11) | 20) & 0xFu; }
#define XB_SPIN(cond, bar) do { unsigned _sp = 0; while (cond) { __builtin_amdgcn_s_sleep(1); \
    if ((++_sp & 255u) == 0u) { if (xb_ld(&(bar)[XB_TMO])) break; if (_sp > XB_SPIN_CAP) { atomicAdd(&(bar)[XB_TMO], 1u); break; } } } } while (0)
struct XcdBarrier { unsigned* bar; unsigned x; volatile LAS unsigned* st; };
__device__ __forceinline__ XcdBarrier xcd_barrier_post(unsigned* bar, volatile LAS unsigned* st) {
    XcdBarrier b; b.bar = bar; b.x = xb_xcc_id(); b.st = st;
    if (opaque_tid_full() == 0) (void)xb_add(&bar[XB_XCNT(b.x)], 1u);
    return b;
}
__device__ __forceinline__ void xcd_barrier_complete(unsigned* bar, unsigned x, unsigned& nloc, unsigned& nx) {
    const unsigned G = gridDim.x * gridDim.y * gridDim.z;
    unsigned sum, cnt, mine, sp = 0u;
    for (;;) {
        sum = 0u; cnt = 0u; mine = 0u;
#pragma unroll
        for (unsigned j = 0; j < 16; ++j) { const unsigned c = xb_ld(&bar[XB_XCNT(j)]); sum += c; cnt += (c > 0u) ? 1u : 0u; mine = (j == x) ? c : mine; }
        if (sum == G) break;
        __builtin_amdgcn_s_sleep(1);
        if ((++sp & 255u) == 0u) { if (xb_ld(&bar[XB_TMO])) break; if (sp > XB_SPIN_CAP) { atomicAdd(&bar[XB_TMO], 1u); break; } }
    }
    nloc = mine > 0u ? mine : 1u; nx = cnt > 0u ? cnt : 1u;
}
__device__ __forceinline__ void xcd_barrier(const XcdBarrier& b) {
    asm volatile("s_waitcnt vmcnt(0)" ::: "memory");
    __syncthreads();
    if (opaque_tid_full() == 0) {
        unsigned* bar = b.bar;
        __builtin_amdgcn_s_waitcnt(0);
        unsigned nloc = b.st[0], nx = b.st[1];
        if (nloc == 0u) { xcd_barrier_complete(bar, b.x, nloc, nx); b.st[0] = nloc; b.st[1] = nx; }
        const unsigned old = xb_add(&bar[XB_XSUB(b.x)], 1u);
        const unsigned gen = old / nloc;
        if (old + 1u == (gen + 1u) * nloc) {
            __builtin_amdgcn_fence(__ATOMIC_RELEASE, "agent");
            asm volatile("s_waitcnt vmcnt(0)" ::: "memory");
            const unsigned og = xb_add(&bar[XB_TOP], 1u);
            const unsigned tg = og / nx;
            if (og + 1u == (tg + 1u) * nx) xb_add(&bar[XB_TOPGEN], 1u);
            else XB_SPIN(xb_ld(&bar[XB_TOPGEN]) == tg, bar);
            __builtin_amdgcn_fence(__ATOMIC_ACQUIRE, "agent");
            xb_add(&bar[XB_XGEN(b.x)], 1u);
            asm volatile("s_waitcnt vmcnt(0)" ::: "memory");
        } else {
            XB_SPIN(xb_ld(&bar[XB_XGEN(b.x)]) == gen, bar);
            __builtin_amdgcn_fence(__ATOMIC_ACQUIRE, "agent");
            asm volatile("s_waitcnt vmcnt(0)" ::: "memory");
        }
    }
    __syncthreads();
}

__device__ __forceinline__ void rope_cs(int pos, int fi, float& cs, float& sn) {
    const float freq = exp2f(-(float)fi * 1.6609640474436813f);
    const float ang = (float)pos * freq;
    const float rev = ang * 0.15915494309189535f;
    sn = __builtin_amdgcn_sinf(rev); cs = __builtin_amdgcn_cosf(rev);
}

enum { EPI_BF16 = 0, EPI_VT = 1, EPI_RESID = 2, EPI_SWIGLU = 3, EPI_KHEAD = 4 };
struct Epi {
    bf16_t* obf; int ldc; int ncols;
    float* X; const float* xs0; const float* xs1; const float* gate;
    const bf16_t* proj; const float* ckpe; int lyr;
};

__device__ __forceinline__ int swz(int r, int chunk) {
    const int line = r >> 1; int slot = ((r & 1) << 3) | chunk; slot ^= (line & 15);
    return line * 256 + slot * 16;
}

__device__ __forceinline__ bool tile_at(int nM, int nN, int i, int& tm, int& tn) {
    const int xcd = opaque_bid() & 7;
    const int mx = (nM - xcd + 7) >> 3;
    if (i >= mx * nN) return false;
    const int per = mx * 4, nfull = nN >> 2;
    const int c = i / per;
    if (c < nfull) { const int r = i - c * per; tm = xcd + 8 * (r >> 2); tn = c * 4 + (r & 3); }
    else { const int rem = i - nfull * per; const int tw = nN & 3; tm = xcd + 8 * (rem / tw); tn = nfull * 4 + rem % tw; }
    return true;
}


template <int EPI, bool EARLYW = true, int NI = 4, int MI = 8>
__device__ __forceinline__ void gemm_phase(const bf16_t* __restrict__ A, int lda, const bf16_t* __restrict__ B, int ldb, int M, int N, int K,
                                           const Epi& ep, unsigned char* smem, int mode = 0, int rot = 0) {
    const int t = opaque_tid_full(), lane = t & 63, w = t >> 6;
    const int wr = w >> 2, wc = w & 3;
    const int l15 = lane & 15, lq = lane >> 4;
    const int lrow = t >> 3, lch = t & 7;
    constexpr int NT = 64 * NI, WN = 16 * NI, WM = 16 * MI;
    const int nM = M >> 8, nN = N / NT, nk = K >> 6;
    int istep = gridDim.x >> 3;
    int li = ((opaque_bid() >> 3) + rot) % istep, ltm = 0, ltn = 0, lkt = 0, lim, hrow = 0;
    {
        const int xcd = opaque_bid() & 7;
        const int total = ((nM - xcd + 7) >> 3) * nN;
        const int full = (total / istep) * istep;
        if (mode == 2) {
            if (li >= 2 * (total - full)) return;
            hrow = (li & 1) * 128; li = full + (li >> 1); lim = li + 1; istep = 1;
        } else lim = mode == 1 ? full : total;
    }
    if (li >= lim || !tile_at(nM, nN, li, ltm, ltn)) return;
    const int T = ((lim - li + istep - 1) / istep) * nk;
    int ci = li, ctm = ltm, ctn = ltn, ckt = 0;
    u32x4 xa0, xa1, xa2, xa3, xb0, xb1, xb2, xb3;
    f32x4 acc[MI][NI];
    { float z = 0.f; asm volatile("" : "+v"(z));
#pragma unroll
      for (int i = 0; i < MI; ++i)
#pragma unroll
        for (int j = 0; j < NI; ++j) acc[i][j] = (f32x4){z, z, z, z}; }

    const size_t ars = (size_t)lda * 128, brs = (size_t)ldb * 128;
#define G_LOAD() { \
        const int tl_ = opaque_tid_full(); \
        const unsigned ag0 = (unsigned)((tl_ >> 3) * lda + (tl_ & 7) * 8) * 2u, bg0 = (unsigned)((tl_ >> 3) * ldb + (tl_ & 7) * 8) * 2u; \
        const unsigned char* ga_ = (const unsigned char*)(A + (size_t)(ltm * 256 + hrow) * lda + lkt * 64); \
        const unsigned char* gb_ = (const unsigned char*)(B + (size_t)(ltn * NT) * ldb + lkt * 64); \
        xa0 = *(const u32x4_ma*)(ga_ + ag0); xa1 = *(const u32x4_ma*)(ga_ + ars + ag0); if (MI == 8) { xa2 = *(const u32x4_ma*)(ga_ + 2 * ars + ag0); xa3 = *(const u32x4_ma*)(ga_ + 3 * ars + ag0); } \
        xb0 = *(const u32x4_ma*)(gb_ + bg0); xb1 = *(const u32x4_ma*)(gb_ + brs + bg0); xb2 = *(const u32x4_ma*)(gb_ + 2 * brs + bg0); if (NI == 4) xb3 = *(const u32x4_ma*)(gb_ + 3 * brs + bg0); \
        if (++lkt == nk) { lkt = 0; li += istep; if (li < lim) tile_at(nM, nN, li, ltm, ltn); } }
#define G_WRITE(BUF) { \
        const int tw_ = opaque_tid_full(); \
        unsigned char* d_ = smem + (BUF) * 65536 + swz(tw_ >> 3, tw_ & 7); \
        *(u32x4_ma*)(d_) = xa0; *(u32x4_ma*)(d_ + 8192) = xa1; if (MI == 8) { *(u32x4_ma*)(d_ + 16384) = xa2; *(u32x4_ma*)(d_ + 24576) = xa3; } \
        *(u32x4_ma*)(d_ + 32768) = xb0; *(u32x4_ma*)(d_ + 40960) = xb1; *(u32x4_ma*)(d_ + 49152) = xb2; if (NI == 4) *(u32x4_ma*)(d_ + 57344) = xb3; }
#define G_AF(MIX) __builtin_bit_cast(bf16x8, *(const u32x4_ma*)(s_ + (((MIX) & 1) ? fa1_ : fa0_) + ((MIX) >> 1) * 4096))
#define G_MM(MIX, AFR) { _Pragma("unroll") for (int ni = 0; ni < NI; ++ni) { \
            if (EPI == EPI_VT) acc[(MIX) < MI ? (MIX) : 0][ni] = __builtin_amdgcn_mfma_f32_16x16x32_bf16(AFR, bfr[ni], acc[(MIX) < MI ? (MIX) : 0][ni], 0, 0, 0); \
            else acc[(MIX) < MI ? (MIX) : 0][ni] = __builtin_amdgcn_mfma_f32_16x16x32_bf16(bfr[ni], AFR, acc[(MIX) < MI ? (MIX) : 0][ni], 0, 0, 0); } }
#define G_PIECE(BUF, WOK, XP, XQ, GBASE, RS, GOFF, LOFF, I0) { \
        const int tp_ = opaque_tid_full(); \
        if (WOK) { unsigned char* d_ = smem + ((BUF) ^ 1) * 65536 + (LOFF) + swz(tp_ >> 3, tp_ & 7); \
            *(u32x4_ma*)(d_ + (I0) * 8192) = XP; *(u32x4_ma*)(d_ + ((I0) + 1) * 8192) = XQ; } \
        const unsigned go_ = (unsigned)((tp_ >> 3) * (GOFF) + (tp_ & 7) * 8) * 2u; \
        XP = *(const u32x4_ma*)((GBASE) + (size_t)(I0) * (RS) + go_); XQ = *(const u32x4_ma*)((GBASE) + (size_t)((I0) + 1) * (RS) + go_); }
#define G_PIECE1(BUF, WOK, XP, GBASE, RS, GOFF, LOFF, I0) { \
        const int tp_ = opaque_tid_full(); \
        if (WOK) { unsigned char* d_ = smem + ((BUF) ^ 1) * 65536 + (LOFF) + swz(tp_ >> 3, tp_ & 7); *(u32x4_ma*)(d_ + (I0) * 8192) = XP; } \
        const unsigned go_ = (unsigned)((tp_ >> 3) * (GOFF) + (tp_ & 7) * 8) * 2u; \
        XP = *(const u32x4_ma*)((GBASE) + (size_t)(I0) * (RS) + go_); }
#define G_KS(BUF, KX, HOOK1, HOOK2) { \
        const unsigned char* s_ = smem + (BUF) * 65536; \
        const int tk_ = opaque_tid_full(), lk_ = tk_ & 15, qk_ = (tk_ >> 4) & 3, ra_ = (tk_ >> 8) * WM + lk_, rb_ = ((tk_ >> 6) & 3) * WN + lk_; \
        const unsigned fa0_ = swz(ra_, qk_) ^ (KX), fa1_ = swz(ra_ + 16, qk_) ^ (KX), fb0_ = (32768u + swz(rb_, qk_)) ^ (KX), fb1_ = (32768u + swz(rb_ + 16, qk_)) ^ (KX); \
        bf16x8 bfr[NI]; \
        if (NI == 4) { _Pragma("unroll") for (int j = 0; j < 2; ++j) { \
            bfr[2 * j] = __builtin_bit_cast(bf16x8, *(const u32x4_ma*)(s_ + fb0_ + j * 4096)); \
            bfr[2 * j + 1] = __builtin_bit_cast(bf16x8, *(const u32x4_ma*)(s_ + fb1_ + j * 4096)); } } \
        else { _Pragma("unroll") for (int j = 0; j < NI; ++j) bfr[j] = __builtin_bit_cast(bf16x8, *(const u32x4_ma*)(s_ + ((32768u + swz(rb_ + 16 * j, qk_)) ^ (KX)))); } \
        bf16x8 afA = G_AF(0), afB = G_AF(1), afC = G_AF(2); \
        __builtin_amdgcn_s_setprio(1); \
        if (MI == 8) { \
            G_MM(0, afA); afA = G_AF(3); \
            G_MM(1, afB); afB = G_AF(4); __builtin_amdgcn_sched_barrier(0); \
            HOOK1; \
            G_MM(2, afC); afC = G_AF(5); \
            G_MM(3, afA); afA = G_AF(6); \
            G_MM(4, afB); afB = G_AF(7); \
            G_MM(5, afC); __builtin_amdgcn_sched_barrier(0); \
            HOOK2; \
            G_MM(6, afA); \
            G_MM(7, afB); \
        } else { \
            G_MM(0, afA); afA = G_AF(3); \
            G_MM(1, afB); __builtin_amdgcn_sched_barrier(0); \
            HOOK1; \
            G_MM(2, afC); __builtin_amdgcn_sched_barrier(0); \
            HOOK2; \
            G_MM(3, afA); } \
        __builtin_amdgcn_s_setprio(0); }
#define G_COMPUTE(BUF) { G_KS(BUF, 0u, ;, ;); G_KS(BUF, 64u, ;, ;); }
#define G_STEP(BUF, SIDX) { \
        if (EARLYW) { \
            const bool wok_ = (SIDX) + 1 < T; \
            const unsigned char* ga_ = (const unsigned char*)(A + (size_t)(ltm * 256 + hrow) * lda + lkt * 64); \
            const unsigned char* gb_ = (const unsigned char*)(B + (size_t)(ltn * NT) * ldb + lkt * 64); \
            G_KS(BUF, 0u, G_PIECE(BUF, wok_, xa0, xa1, ga_, ars, lda, 0, 0), if (MI == 8) G_PIECE(BUF, wok_, xa2, xa3, ga_, ars, lda, 0, 2)); \
            G_KS(BUF, 64u, G_PIECE(BUF, wok_, xb0, xb1, gb_, brs, ldb, 32768, 0), if (NI == 4) G_PIECE(BUF, wok_, xb2, xb3, gb_, brs, ldb, 32768, 2) else G_PIECE1(BUF, wok_, xb2, gb_, brs, ldb, 32768, 2)); \
            if (++lkt == nk) { lkt = 0; li += istep; if (li < lim) tile_at(nM, nN, li, ltm, ltn); } } \
        else { G_LOAD(); G_COMPUTE(BUF); if ((SIDX) + 1 < T) G_WRITE((BUF) ^ 1); } }

    G_LOAD();
    G_WRITE(0);
    if (EARLYW) G_LOAD();
    __syncthreads();
    for (int s = 0; s < T; s += 2) {
        G_STEP(0, s);
        __syncthreads();
        G_STEP(1, s + 1);
        ckt += 2;
        if (ckt == nk) {
            { const int m0 = ctm * 256 + hrow, n0 = ctn * NT;
              const int te = opaque_tid_full(), le = te & 63, l15 = le & 15, lq = le >> 4, wr = te >> 8, wc = (te >> 6) & 3;
    if (EPI == EPI_VT) {
#pragma unroll
        for (int mi = 0; mi < MI; ++mi)
#pragma unroll
            for (int ni = 0; ni < NI; ++ni) {
                const int m = m0 + wr * WM + mi * 16 + lq * 4, n = n0 + wc * WN + ni * 16 + l15;
                uint2 v; v.x = pack2(acc[mi][ni][0], acc[mi][ni][1]); v.y = pack2(acc[mi][ni][2], acc[mi][ni][3]);
                *(uint2*)(ep.obf + (size_t)n * ep.ldc + m) = v;
            }
    } else if (EPI == EPI_BF16) {
#pragma unroll
        for (int mi = 0; mi < MI; ++mi)
#pragma unroll
            for (int ni = 0; ni < NI; ++ni) {
                const int row = m0 + wr * WM + mi * 16 + l15, col = n0 + wc * WN + ni * 16 + lq * 4;
                if (col < ep.ncols) {
                    uint2 v; v.x = pack2(acc[mi][ni][0], acc[mi][ni][1]); v.y = pack2(acc[mi][ni][2], acc[mi][ni][3]);
                    *(uint2*)(ep.obf + (size_t)row * ep.ldc + col) = v;
                }
            }
    } else if (EPI == EPI_RESID) {
#pragma unroll
        for (int mi = 0; mi < MI; ++mi) {
            const int row = m0 + wr * WM + mi * 16 + l15;
            const float* src = row < 8192 ? ep.xs0 + (size_t)row * 1024 : ep.xs1 + (size_t)(row - 8192) * 1024;
            const int cond = row < 8192 ? 0 : 1 + ((row - 8192) >> 11);
            const float* g = ep.gate + cond * 6144;
            float* dst = ep.X + (size_t)row * 1024;
#pragma unroll
            for (int ni = 0; ni < NI; ++ni) {
                const int col = n0 + wc * WN + ni * 16 + lq * 4;
                const f32x4 xv = *(const f32x4*)(src + col);
                const f32x4 gv = *(const f32x4*)(g + col);
                f32x4 o = xv + gv * acc[mi][ni];
                *(f32x4*)(dst + col) = o;
            }
        }
    } else if (EPI == EPI_KHEAD) {
        const int h = (n0 >> 6) + wc;
        const float* kg = ep.gate;
        int ttype, tb = 0, tt0 = 0;
        if (m0 < 8192) ttype = 0;
        else { const int r2 = m0 - 8192; tb = r2 / 2304; tt0 = r2 - tb * 2304; ttype = tt0 < 2048 ? 1 : 2; }
#pragma unroll
        for (int mi = 0; mi < MI; ++mi) {
            const int rl = wr * WM + mi * 16 + l15;
            const int row = m0 + rl;
            float kp[8];
            if (ttype == 2) {
                const float* cs_ = ep.ckpe + ((size_t)((tb * 2 + ep.lyr) * 256 + (tt0 - 2048 + rl))) * 32 + lq * 8;
                const float4 c0 = *(const float4*)cs_, c1 = *(const float4*)(cs_ + 4);
                kp[0] = c0.x; kp[1] = c0.y; kp[2] = c0.z; kp[3] = c0.w; kp[4] = c1.x; kp[5] = c1.y; kp[6] = c1.z; kp[7] = c1.w;
            } else {
                const int msrc = ttype == 0 ? row : 8192 + tb * 2048 + tt0 + rl;
                const uint4 u = *(const uint4*)(ep.proj + (size_t)msrc * INC + 384 + lq * 8);
                kp[0] = bflo(u.x); kp[1] = bfhi(u.x); kp[2] = bflo(u.y); kp[3] = bfhi(u.y); kp[4] = bflo(u.z); kp[5] = bfhi(u.z); kp[6] = bflo(u.w); kp[7] = bfhi(u.w);
            }
            float ss = 0.f;
#pragma unroll
            for (int ni = 0; ni < NI; ++ni)
#pragma unroll
                for (int r = 0; r < 4; ++r) ss += acc[mi][ni][r] * acc[mi][ni][r];
#pragma unroll
            for (int j = 0; j < 8; ++j) ss += kp[j] * kp[j];
            ss += __shfl_xor(ss, 16); ss += __shfl_xor(ss, 32);
            const float rs = rsqrtf(ss * (1.f / 96.f) + EPS);
            bf16_t* dst = ep.obf + (size_t)row * 768 + h * 96;
#pragma unroll
            for (int ni = 0; ni < NI; ++ni) {
                const float4 gv = *(const float4*)(kg + ni * 16 + lq * 4);
                uint2 v; v.x = pack2(acc[mi][ni][0] * rs * gv.x, acc[mi][ni][1] * rs * gv.y); v.y = pack2(acc[mi][ni][2] * rs * gv.z, acc[mi][ni][3] * rs * gv.w);
                *(uint2*)(dst + ni * 16 + lq * 4) = v;
            }
            const float4 g0 = *(const float4*)(kg + 64 + lq * 8), g1 = *(const float4*)(kg + 64 + lq * 8 + 4);
            kp[0] *= rs * g0.x; kp[1] *= rs * g0.y; kp[2] *= rs * g0.z; kp[3] *= rs * g0.w; kp[4] *= rs * g1.x; kp[5] *= rs * g1.y; kp[6] *= rs * g1.z; kp[7] *= rs * g1.w;
            if (ttype == 1) {
                const int tt = tt0 + rl;
                const int pos = lq < 2 ? (tt >> 6) : (tt & 63);
#pragma unroll
                for (int j = 0; j < 8; ++j) {
                    const float pv = __shfl_xor(kp[j], 16);
                    float cs, sn; rope_cs(pos, j, cs, sn);
                    kp[j] = (lq & 1) ? (kp[j] * cs + pv * sn) : (kp[j] * cs - pv * sn);
                }
            }
            uint4 o; o.x = pack2(kp[0], kp[1]); o.y = pack2(kp[2], kp[3]); o.z = pack2(kp[4], kp[5]); o.w = pack2(kp[6], kp[7]);
            *(uint4*)(dst + 64 + lq * 8) = o;
            asm volatile("" ::: "memory");
        }
    } else {
#pragma unroll
        for (int mi = 0; mi < MI; ++mi) {
            const int row = m0 + wr * WM + mi * 16 + l15;
#pragma unroll
            for (int ni = 0; ni < 2; ++ni) {
                const int col = ((n0 + wc * 64) >> 1) + ni * 16 + lq * 4;
                float a[4];
#pragma unroll
                for (int r = 0; r < 4; ++r) { const float gv = acc[mi][ni][r], uv = acc[mi][ni + 2][r]; a[r] = gv * __builtin_amdgcn_rcpf(1.f + __expf(-gv)) * uv; }
                uint2 v; v.x = pack2(a[0], a[1]); v.y = pack2(a[2], a[3]);
                *(uint2*)(ep.obf + (size_t)row * ep.ldc + col) = v;
            }
        }
    }
            }
            { float z = 0.f; asm volatile("" : "+v"(z));
#pragma unroll
              for (int i = 0; i < MI; ++i)
#pragma unroll
                for (int j = 0; j < NI; ++j) acc[i][j] = (f32x4){z, z, z, z}; }
            ckt = 0; ci += istep; if (ci < lim) tile_at(nM, nN, ci, ctm, ctn);
            asm volatile("s_waitcnt vmcnt(0)" ::: "memory");
        }
        __syncthreads();
    }
    asm volatile("s_waitcnt vmcnt(0)" ::: "memory");
#undef G_LOAD
#undef G_WRITE
#undef G_COMPUTE
#undef G_KS
#undef G_PIECE
#undef G_PIECE1
#undef G_AF
#undef G_MM
#undef G_STEP
}

__device__ __forceinline__ void mod_item(PP p, int it, unsigned char* smem) {
    const int l = it / 192, c0 = (it % 192) * 32;
    float* ssil = (float*)smem;
    float* red = ssil + 5 * 1024;
    const int t = opaque_tid();
    for (int idx = t; idx < 5 * 1024; idx += 256) {
        const int ci = idx >> 10, k = idx & 1023;
        const float v = ci == 0 ? p->in[6][k] : p->in[5][(ci - 1) * 1024 + k];
        ssil[idx] = v / (1.f + __expf(-v));
    }
    __syncthreads();
    const int kg = t >> 5, cj = t & 31;
    const float* wp = p->in[7] + (size_t)l * 1024 * 6144 + (size_t)(kg * 128) * 6144 + c0 + cj;
    float a0 = 0.f, a1 = 0.f, a2 = 0.f, a3 = 0.f, a4 = 0.f;
    int wstride = 6144; asm volatile("" : "+s"(wstride));
#pragma unroll 16
    for (int k = 0; k < 128; ++k) {
        const float wv = __builtin_nontemporal_load(wp + (size_t)(k * wstride));
        const int kk = kg * 128 + k;
        a0 += ssil[kk] * wv; a1 += ssil[1024 + kk] * wv; a2 += ssil[2048 + kk] * wv; a3 += ssil[3072 + kk] * wv; a4 += ssil[4096 + kk] * wv;
    }
    red[(kg * 5 + 0) * 32 + cj] = a0; red[(kg * 5 + 1) * 32 + cj] = a1; red[(kg * 5 + 2) * 32 + cj] = a2;
    red[(kg * 5 + 3) * 32 + cj] = a3; red[(kg * 5 + 4) * 32 + cj] = a4;
    __syncthreads();
    if (t < 160) {
        const int i = t >> 5, cc = t & 31;
        float s = p->in[8][l * 6144 + c0 + cc];
#pragma unroll
        for (int g = 0; g < 8; ++g) s += red[(g * 5 + i) * 32 + cc];
        ((float*)(p->ws + WS_MOD))[(l * 5 + i) * 6144 + c0 + cc] = s;
    }
    __syncthreads();
}

constexpr int CONV_ITEMS = 6001;
__device__ __forceinline__ void conv_item(PP p, int l, int it, unsigned char* smem) {
    const int t = opaque_tid();
    const float* W; int N, K, mat, idx; bf16_t* dst; const float* ksc = nullptr;
    if (it < 1104) { mat = 0; idx = it; W = p->in[11] + (size_t)l * 1024 * 2208; N = 2208; K = 1024; dst = (bf16_t*)(p->ws + WS_WIN); }
    else if (it < 1200) { mat = 1; idx = it - 1104; W = p->in[14] + (size_t)l * 256 * 768; N = 768; K = 256; dst = (bf16_t*)(p->ws + WS_WQUP); ksc = p->in[12] + l * 256; }
    else if (it < 1264) { mat = 2; idx = it - 1200; W = p->in[15] + (size_t)l * 128 * 1024; N = 1024; K = 128; dst = (bf16_t*)(p->ws + WS_WKV); }
    else if (it < 1776) { mat = 3; idx = it - 1264; W = p->in[21] + (size_t)l * 1024 * 1024; N = 1024; K = 1024; dst = (bf16_t*)(p->ws + WS_WO); }
    else if (it < 3184) { mat = 4; idx = it - 1776; W = p->in[22] + (size_t)l * 1024 * 2816; N = 2816; K = 1024; dst = (bf16_t*)(p->ws + WS_WGU); }
    else if (it < 4592) { mat = 5; idx = it - 3184; W = p->in[23] + (size_t)l * 1024 * 2816; N = 2816; K = 1024; dst = (bf16_t*)(p->ws + WS_WGU); }
    else if (it < 6000) { mat = 6; idx = it - 4592; W = p->in[24] + (size_t)l * 2816 * 1024; N = 1024; K = 2816; dst = (bf16_t*)(p->ws + WS_WDN); }
    else {
        uint4* z = (uint4*)(p->ws + WS_WIN + (size_t)2208 * 1024 * 2);
        unsigned zz = 0u; asm volatile("" : "+v"(zz));
        for (int i = t; i < 96 * 1024 * 2 / 16; i += 256) z[i] = make_uint4(zz, zz, zz, zz);
        return;
    }
    const int nNt = N >> 5;
    const int nt = idx % nNt, kt = idx / nNt;
    const int k0 = kt * 64 + (t >> 5) * 8, c = nt * 32 + (t & 31);
    const float* src = W + (size_t)k0 * N + c;
    float v[8];
#pragma unroll
    for (int j = 0; j < 8; ++j) v[j] = __builtin_nontemporal_load(src + (size_t)j * N);
    if (ksc) {
        const float4 s0 = *(const float4*)(ksc + k0), s1 = *(const float4*)(ksc + k0 + 4);
        v[0] *= s0.x; v[1] *= s0.y; v[2] *= s0.z; v[3] *= s0.w; v[4] *= s1.x; v[5] *= s1.y; v[6] *= s1.z; v[7] *= s1.w;
    }
    int orow;
    if (mat == 2) { const int h = c >> 7, j = c & 127; orow = j < 64 ? h * 64 + j : 512 + h * 64 + (j - 64); }
    else if (mat == 4) { orow = (c >> 5) * 64 + (c & 31); }
    else if (mat == 5) { orow = (c >> 5) * 64 + 32 + (c & 31); }
    else orow = c;
    uint4 o; o.x = pack2(v[0], v[1]); o.y = pack2(v[2], v[3]); o.z = pack2(v[4], v[5]); o.w = pack2(v[6], v[7]);
    *(uint4*)(dst + (size_t)orow * K + k0) = o;
}

__device__ __forceinline__ void norm_item(PP p, int l, int it, int which  ) {
    const int t = opaque_tid(), lane = t & 63, w = t >> 6;
    const int m0 = it * 8 + w * 2;
    const float* src0;
    if (which == 0 && l == 0) src0 = m0 < 8192 ? p->in[0] + (size_t)m0 * 1024 : p->in[1] + (size_t)(m0 - 8192) * 1024;
    else src0 = p->out + (size_t)m0 * 1024;
    float4 x[2][4];
#pragma unroll
    for (int r = 0; r < 2; ++r)
#pragma unroll
        for (int i = 0; i < 4; ++i) x[r][i] = *(const float4*)(src0 + r * 1024 + lane * 4 + 256 * i);
    const int cond = m0 < 8192 ? 0 : 1 + ((m0 - 8192) >> 11);
    const float* mod = (const float*)(p->ws + WS_MOD) + (l * 5 + cond) * 6144 + which * 3072;
    const float* g = (which == 0 ? p->in[9] : p->in[10]) + l * 1024;
    float ss0 = 0.f, ss1 = 0.f;
#pragma unroll
    for (int i = 0; i < 4; ++i) {
        ss0 += x[0][i].x * x[0][i].x + x[0][i].y * x[0][i].y + x[0][i].z * x[0][i].z + x[0][i].w * x[0][i].w;
        ss1 += x[1][i].x * x[1][i].x + x[1][i].y * x[1][i].y + x[1][i].z * x[1][i].z + x[1][i].w * x[1][i].w;
    }
#pragma unroll
    for (int o = 32; o; o >>= 1) { ss0 += __shfl_xor(ss0, o); ss1 += __shfl_xor(ss1, o); }
    const float rs0 = rsqrtf(ss0 * (1.f / 1024.f) + EPS), rs1 = rsqrtf(ss1 * (1.f / 1024.f) + EPS);
    bf16_t* dst = (bf16_t*)(p->ws + WS_HM) + (size_t)m0 * 1024;
#pragma unroll
    for (int i = 0; i < 4; ++i) {
        const int col = lane * 4 + 256 * i;
        const float4 gv = *(const float4*)(g + col), sh = *(const float4*)(mod + col), sc = *(const float4*)(mod + 1024 + col);
        const float a0 = gv.x * (1.f + sc.x), a1 = gv.y * (1.f + sc.y), a2 = gv.z * (1.f + sc.z), a3 = gv.w * (1.f + sc.w);
        uint2 o0, o1;
        o0.x = pack2(x[0][i].x * rs0 * a0 + sh.x, x[0][i].y * rs0 * a1 + sh.y); o0.y = pack2(x[0][i].z * rs0 * a2 + sh.z, x[0][i].w * rs0 * a3 + sh.w);
        o1.x = pack2(x[1][i].x * rs1 * a0 + sh.x, x[1][i].y * rs1 * a1 + sh.y); o1.y = pack2(x[1][i].z * rs1 * a2 + sh.z, x[1][i].w * rs1 * a3 + sh.w);
        *(uint2*)(dst + col) = o0;
        *(uint2*)(dst + 1024 + col) = o1;
    }
}

__device__ __forceinline__ float log_sigmoid(float x) { return -log1pf(expf(-x)); }

__device__ __forceinline__ void phaseC_item(PP p, int l, int it, unsigned char* smem) {
    const int c = it >> 2, hs = it & 3;
    const int t = opaque_tid(), lane = t & 63, w = t >> 6;
    const bf16_t* PROJ = (const bf16_t*)(p->ws + WS_PROJ);
    bf16_t* CKV = (bf16_t*)(p->ws + WS_CKV);
    bf16_t* MIX = (bf16_t*)(p->ws + WS_HM);
    float* MSQ = (float*)(p->ws + WS_MSQ);
    constexpr int UROW = 272, UKF = 0, UKB = 64 * UROW, UVT = 128 * UROW;
    {
        const float lgf = log_sigmoid(p->in[19][l * 4 + hs]), lgb = log_sigmoid(p->in[20][l * 4 + hs]);
#pragma unroll
        for (int i = 0; i < 4; ++i) {
            const int idx = t + 256 * i, a = idx >> 3, cc = (idx & 7) * 8;
            const bf16_t* pr = PROJ + (size_t)(c * 128 + a) * INC + hs * 64 + cc;
            const uint4 kv = *(const uint4*)(pr + 1440), vv = *(const uint4*)(pr + 1696);
            const float df = expf(lgf * (float)(127 - a)) * 0.125f, db = expf(lgb * (float)a) * 0.125f;
            const float kx[8] = {bflo(kv.x), bfhi(kv.x), bflo(kv.y), bfhi(kv.y), bflo(kv.z), bfhi(kv.z), bflo(kv.w), bfhi(kv.w)};
            const unsigned vw[4] = {vv.x, vv.y, vv.z, vv.w};
            bf16_t* kf = (bf16_t*)(smem + UKF) + a; bf16_t* kb = (bf16_t*)(smem + UKB) + a; bf16_t* vt = (bf16_t*)(smem + UVT) + a;
#pragma unroll
            for (int j = 0; j < 8; j += 2) {
                const unsigned pf = pack2(kx[j] * df, kx[j + 1] * df), pb = pack2(kx[j] * db, kx[j + 1] * db);
                kf[(cc + j) * (UROW / 2)] = (bf16_t)(pf & 0xffffu); kf[(cc + j + 1) * (UROW / 2)] = (bf16_t)(pf >> 16);
                kb[(cc + j) * (UROW / 2)] = (bf16_t)(pb & 0xffffu); kb[(cc + j + 1) * (UROW / 2)] = (bf16_t)(pb >> 16);
                vt[(cc + j) * (UROW / 2)] = (bf16_t)(vw[j >> 1] & 0xffffu); vt[(cc + j + 1) * (UROW / 2)] = (bf16_t)(vw[j >> 1] >> 16);
            }
        }
    }
    const float* kvg = p->in[13] + l * 128;
    const float* cw = p->in[18] + l * 768;
    for (int tt = 0; tt < 8; ++tt) {
        const int m = c * 128 + hs * 32 + w * 8 + tt;
        const bf16_t* pr = PROJ + (size_t)m * INC;
        const uint2 qv = *(const uint2*)(pr + lane * 4);
        const float q0 = bflo(qv.x), q1 = bfhi(qv.x), q2 = bflo(qv.y), q3 = bfhi(qv.y);
        const float ssq = wave_sum(q0 * q0 + q1 * q1 + q2 * q2 + q3 * q3);
        if (lane == 0) MSQ[m] = ssq * (1.f / 256.f) + EPS;
        const unsigned kvv = *(const unsigned*)(pr + 256 + lane * 2);
        const float k0 = bflo(kvv), k1 = bfhi(kvv);
        const float s2 = wave_sum(k0 * k0 + k1 * k1);
        const float rs = rsqrtf(s2 * (1.f / 128.f) + EPS);
        const float c0v = k0 * rs * kvg[lane * 2], c1v = k1 * rs * kvg[lane * 2 + 1];
        const bool ctx = m < 8192;
        const int kvrow = ctx ? m : m + ((m - 8192) >> 11) * 256;
        *(unsigned*)(CKV + (size_t)kvrow * 128 + lane * 2) = pack2(c0v, c1v);
        if (ctx) {
            const int b = m >> 8, tq = m & 255;
            const size_t orow = (size_t)((b * 2 + l) * 256 + tq);
            *(float2*)(p->out + OUT_CKV + orow * 128 + lane * 2) = make_float2(c0v, c1v);
            if (lane < 32) p->out[OUT_KPE + orow * 32 + lane] = bf2f(pr[384 + lane]);
        }
        const int tseq = ctx ? (m & 255) : ((m - 8192) & 2047);
        const int tlen = ctx ? 256 : 2048;
        const int ch = lane * 4;
        const uint2 gbv = *(const uint2*)(pr + 416 + ch);
        const uint2 gcv = *(const uint2*)(pr + 672 + ch), xv = *(const uint2*)(pr + 928 + ch);
        float uc[4] = {bflo(gcv.x) * bflo(xv.x), bfhi(gcv.x) * bfhi(xv.x), bflo(gcv.y) * bflo(xv.y), bfhi(gcv.y) * bfhi(xv.y)};
        float up[4] = {0.f, 0.f, 0.f, 0.f}, un[4] = {0.f, 0.f, 0.f, 0.f};
        if (tseq > 0) {
            const uint2 g2 = *(const uint2*)(pr - INC + 672 + ch), x2 = *(const uint2*)(pr - INC + 928 + ch);
            up[0] = bflo(g2.x) * bflo(x2.x); up[1] = bfhi(g2.x) * bfhi(x2.x); up[2] = bflo(g2.y) * bflo(x2.y); up[3] = bfhi(g2.y) * bfhi(x2.y);
        }
        if (tseq < tlen - 1) {
            const uint2 g2 = *(const uint2*)(pr + INC + 672 + ch), x2 = *(const uint2*)(pr + INC + 928 + ch);
            un[0] = bflo(g2.x) * bflo(x2.x); un[1] = bfhi(g2.x) * bfhi(x2.x); un[2] = bflo(g2.y) * bflo(x2.y); un[3] = bfhi(g2.y) * bfhi(x2.y);
        }
        const float4 w0 = *(const float4*)(cw + ch), w1 = *(const float4*)(cw + 256 + ch), w2 = *(const float4*)(cw + 512 + ch);
        const float y0 = bflo(gbv.x) * (w0.x * up[0] + w1.x * uc[0] + w2.x * un[0]);
        const float y1 = bfhi(gbv.x) * (w0.y * up[1] + w1.y * uc[1] + w2.y * un[1]);
        const float y2 = bflo(gbv.y) * (w0.z * up[2] + w1.z * uc[2] + w2.z * un[2]);
        const float y3 = bfhi(gbv.y) * (w0.w * up[3] + w1.w * uc[3] + w2.w * un[3]);
        uint2 o; o.x = pack2(y0, y1); o.y = pack2(y2, y3);
        *(uint2*)(MIX + (size_t)m * 1024 + 512 + ch) = o;
    }
    {
        const int j2 = it * 2 + (t >> 7), col = t & 127;
        const int b = j2 >> 8, j = j2 & 255;
        const float v = p->in[2][((size_t)((b * 2 + l) * 256 + j)) * 128 + col];
        CKV[(size_t)(8192 + b * 2304 + 2048 + j) * 128 + col] = (bf16_t)(pack2(v, v) & 0xffffu);
    }
    __syncthreads();
    {
        const int l15 = lane & 15, lq = lane >> 4;
        f32x4 uf[4], ub[4];
#pragma unroll
        for (int ni = 0; ni < 4; ++ni) { uf[ni] = (f32x4){0.f, 0.f, 0.f, 0.f}; ub[ni] = (f32x4){0.f, 0.f, 0.f, 0.f}; }
#pragma unroll
        for (int ks = 0; ks < 4; ++ks) {
            const unsigned ko = (ks * 32 + lq * 8) * 2;
            const bf16x8 af = *(const bf16x8*)(smem + UKF + (w * 16 + l15) * UROW + ko);
            const bf16x8 ab = *(const bf16x8*)(smem + UKB + (w * 16 + l15) * UROW + ko);
#pragma unroll
            for (int ni = 0; ni < 4; ++ni) {
                const bf16x8 vf = *(const bf16x8*)(smem + UVT + (ni * 16 + l15) * UROW + ko);
                uf[ni] = __builtin_amdgcn_mfma_f32_16x16x32_bf16(af, vf, uf[ni], 0, 0, 0);
                ub[ni] = __builtin_amdgcn_mfma_f32_16x16x32_bf16(ab, vf, ub[ni], 0, 0, 0);
            }
        }
        float* U = (float*)(p->ws + WS_U) + (size_t)((c * 4 + hs) * 2) * 4096;
#pragma unroll
        for (int ni = 0; ni < 4; ++ni)
#pragma unroll
            for (int r = 0; r < 4; ++r) {
                const int o = (w * 16 + lq * 4 + r) * 64 + ni * 16 + l15;
                U[o] = uf[ni][r]; U[4096 + o] = ub[ni][r];
            }
    }
    __syncthreads();
}

__device__ __forceinline__ void phaseE_item(PP p, int l, int it) {
    const int t = opaque_tid(), lane = t & 63, w = t >> 6;
    const int row = it * 4 + w;
    const int h = lane >> 3, pp = lane & 7;
    const bf16_t* PROJ = (const bf16_t*)(p->ws + WS_PROJ);
    const bf16_t* KRAW = (const bf16_t*)(p->ws + WS_KRAW);
    bf16_t* KB = (bf16_t*)(p->ws + WS_KB);
    float kp[4]; bool rope = false; int trow = 0, tcol = 0;
    int msrc = -1; size_t csrc = 0;
    if (row < 8192) msrc = row;
    else {
        const int r2 = row - 8192, b = r2 / 2304, tt = r2 - b * 2304;
        if (tt < 2048) { msrc = 8192 + b * 2048 + tt; rope = true; trow = tt >> 6; tcol = tt & 63; }
        else csrc = ((size_t)((b * 2 + l) * 256 + (tt - 2048))) * 32;
    }
    if (msrc >= 0) {
        const uint2 v = *(const uint2*)(PROJ + (size_t)msrc * INC + 384 + pp * 4);
        kp[0] = bflo(v.x); kp[1] = bfhi(v.x); kp[2] = bflo(v.y); kp[3] = bfhi(v.y);
    } else {
        const float4 v = *(const float4*)(p->in[3] + csrc + pp * 4);
        kp[0] = v.x; kp[1] = v.y; kp[2] = v.z; kp[3] = v.w;
    }
    const uint4 kn4 = *(const uint4*)(KRAW + (size_t)row * 512 + h * 64 + pp * 8);
    float kn[8] = {bflo(kn4.x), bfhi(kn4.x), bflo(kn4.y), bfhi(kn4.y), bflo(kn4.z), bfhi(kn4.z), bflo(kn4.w), bfhi(kn4.w)};
    float ss = 0.f;
#pragma unroll
    for (int j = 0; j < 8; ++j) ss += kn[j] * kn[j];
#pragma unroll
    for (int j = 0; j < 4; ++j) ss += kp[j] * kp[j];
    ss += __shfl_xor(ss, 1); ss += __shfl_xor(ss, 2); ss += __shfl_xor(ss, 4);
    const float rs = rsqrtf(ss * (1.f / 96.f) + EPS);
    const float* g = p->in[17] + l * 96;
#pragma unroll
    for (int j = 0; j < 8; ++j) kn[j] *= rs * g[pp * 8 + j];
#pragma unroll
    for (int j = 0; j < 4; ++j) kp[j] *= rs * g[64 + pp * 4 + j];
    float pv[4];
#pragma unroll
    for (int j = 0; j < 4; ++j) pv[j] = __shfl_xor(kp[j], 2);
    if (rope) {
        const int pos = pp < 4 ? trow : tcol;
#pragma unroll
        for (int j = 0; j < 4; ++j) {
            float cs, sn; rope_cs(pos, 4 * (pp & 1) + j, cs, sn);
            kp[j] = (pp & 2) ? (kp[j] * cs + pv[j] * sn) : (kp[j] * cs - pv[j] * sn);
        }
    }
    bf16_t* dst = KB + (size_t)row * 768 + h * 96;
    uint4 o; o.x = pack2(kn[0], kn[1]); o.y = pack2(kn[2], kn[3]); o.z = pack2(kn[4], kn[5]); o.w = pack2(kn[6], kn[7]);
    *(uint4*)(dst + pp * 8) = o;
    uint2 o2; o2.x = pack2(kp[0], kp[1]); o2.y = pack2(kp[2], kp[3]);
    *(uint2*)(dst + 64 + pp * 4) = o2;
}

constexpr int AT_KROW = 208, AT_VROW = 136, AT_VOFF = 64 * AT_KROW, AT_BUF = AT_VOFF + 64 * AT_VROW;
__device__ __forceinline__ void attn_item(PP p, int l, int ait, unsigned char* smem) {
    const int t = opaque_tid(), lane = t & 63, w = t >> 6, half = lane >> 5, ql = lane & 31;
    const bool lat = ait < 512;
    int b, h, qb, mq0, kv0, ntile;
    if (lat) { b = ait >> 7; h = (ait >> 4) & 7; qb = ait & 15; mq0 = 8192 + b * 2048 + qb * 128; kv0 = 8192 + b * 2304; ntile = 36; }
    else { const int i2 = ait - 512; b = i2 >> 4; h = (i2 >> 1) & 7; qb = i2 & 1; mq0 = b * 256 + qb * 128; kv0 = b * 256; ntile = 4; }
    const int m = mq0 + w * 32 + ql;
    const bf16_t* KBp = (const bf16_t*)(p->ws + WS_KB) + (size_t)kv0 * 768 + h * 96;
    const bf16_t* VTp = (const bf16_t*)(p->ws + WS_VT) + (size_t)(h * 64) * NKV + kv0;
    const int kr0 = t / 12, kc0 = t - kr0 * 12, kr1 = (t + 256) / 12, kc1 = (t + 256) - kr1 * 12, kr2 = (t + 512) / 12, kc2 = (t + 512) - kr2 * 12;
    const int vd0 = t >> 3, vd1 = (t + 256) >> 3, vc = t & 7;
    const unsigned kg0 = kr0 * 768 + kc0 * 8, kg1 = kr1 * 768 + kc1 * 8, kg2 = kr2 * 768 + kc2 * 8;
    const unsigned vg0 = vd0 * NKV + vc * 8, vg1 = vd1 * NKV + vc * 8;
    const unsigned kl0 = kr0 * AT_KROW + kc0 * 16, kl1 = kr1 * AT_KROW + kc1 * 16, kl2 = kr2 * AT_KROW + kc2 * 16;
    const unsigned vl0 = AT_VOFF + vd0 * AT_VROW + vc * 16, vl1 = AT_VOFF + vd1 * AT_VROW + vc * 16;
    bf16x8 qf[6];
    {
        const bf16_t* qsrc = (const bf16_t*)(p->ws + WS_QRAW) + (size_t)m * 768 + h * 96 + half * 8;
        float qv[6][8];
        float ss = 0.f;
#pragma unroll
        for (int ks = 0; ks < 6; ++ks) {
            const uint4 u = *(const uint4*)(qsrc + ks * 16);
            qv[ks][0] = bflo(u.x); qv[ks][1] = bfhi(u.x); qv[ks][2] = bflo(u.y); qv[ks][3] = bfhi(u.y);
            qv[ks][4] = bflo(u.z); qv[ks][5] = bfhi(u.z); qv[ks][6] = bflo(u.w); qv[ks][7] = bfhi(u.w);
#pragma unroll
            for (int j = 0; j < 8; ++j) ss += qv[ks][j] * qv[ks][j];
        }
        ss += __shfl_xor(ss, 32);
        const float msq = ((const float*)(p->ws + WS_MSQ))[m];
        const float rs = rsqrtf(ss * (1.f / 96.f) + EPS * msq);
        const float* qg = p->in[16] + l * 96 + half * 8;
#pragma unroll
        for (int ks = 0; ks < 6; ++ks)
#pragma unroll
            for (int j = 0; j < 8; ++j) qv[ks][j] *= rs * qg[ks * 16 + j];
        if (lat) {
            const int tt = qb * 128 + w * 32 + ql;
#pragma unroll
            for (int ks = 4; ks < 6; ++ks) {
                const int pos = ks == 4 ? (tt >> 6) : (tt & 63);
#pragma unroll
                for (int j = 0; j < 8; ++j) {
                    const float pv = __shfl_xor(qv[ks][j], 32);
                    float cs, sn; rope_cs(pos, j, cs, sn);
                    qv[ks][j] = half ? (qv[ks][j] * cs + pv * sn) : (qv[ks][j] * cs - pv * sn);
                }
            }
        }
        constexpr float QS = 0.10206207261596577f * 1.4426950408889634f;
#pragma unroll
        for (int ks = 0; ks < 6; ++ks)
            qf[ks] = mk8(pack2(qv[ks][0] * QS, qv[ks][1] * QS), pack2(qv[ks][2] * QS, qv[ks][3] * QS),
                         pack2(qv[ks][4] * QS, qv[ks][5] * QS), pack2(qv[ks][6] * QS, qv[ks][7] * QS));
    }
    uint4 r0k0, r0k1, r0k2, r0v0, r0v1, r1k0, r1k1, r1k2, r1v0, r1v1, r2k0, r2k1, r2k2, r2v0, r2v1;
#define A_LOAD(P, JT) { \
        const int jt_ = (JT) < ntile ? (JT) : ntile - 1; \
        const bf16_t* kp_ = KBp + (size_t)jt_ * (64 * 768); const bf16_t* vp_ = VTp + jt_ * 64; \
        P##k0 = *(const uint4*)(kp_ + kg0); P##k1 = *(const uint4*)(kp_ + kg1); P##k2 = *(const uint4*)(kp_ + kg2); \
        P##v0 = *(const uint4*)(vp_ + vg0); P##v1 = *(const uint4*)(vp_ + vg1); }
#define A_WRITE(P, STG) { \
        unsigned char* nb_ = smem + (STG) * AT_BUF; \
        *(uint4*)(nb_ + kl0) = P##k0; *(uint4*)(nb_ + kl1) = P##k1; *(uint4*)(nb_ + kl2) = P##k2; \
        *(uint2*)(nb_ + vl0) = make_uint2(P##v0.x, P##v0.y); *(uint2*)(nb_ + vl0 + 8) = make_uint2(P##v0.z, P##v0.w); \
        *(uint2*)(nb_ + vl1) = make_uint2(P##v1.x, P##v1.y); *(uint2*)(nb_ + vl1 + 8) = make_uint2(P##v1.z, P##v1.w); }
    A_LOAD(r0, 0);
    A_WRITE(r0, 0);
    A_LOAD(r1, 1);
    A_LOAD(r2, 2);
    __syncthreads();
    f32x16 o0, o1;
#pragma unroll
    for (int r = 0; r < 16; ++r) { o0[r] = 0.f; o1[r] = 0.f; }
    float mrun = -INFINITY, lrun = 0.f;
    const unsigned kfo = ql * AT_KROW + half * 16, vfo = AT_VOFF + ql * AT_VROW + half * 8;
#define A_COMPUTE(STG) { \
        const unsigned char* cur = smem + (STG) * AT_BUF; \
        f32x16 s0, s1; \
        _Pragma("unroll") for (int r = 0; r < 16; ++r) { s0[r] = 0.f; s1[r] = 0.f; } \
        _Pragma("unroll") for (int ks = 0; ks < 6; ++ks) { \
            const bf16x8 k0 = *(const bf16x8*)(cur + kfo + ks * 32); \
            const bf16x8 k1 = *(const bf16x8*)(cur + kfo + 32 * AT_KROW + ks * 32); \
            s0 = __builtin_amdgcn_mfma_f32_32x32x16_bf16(k0, qf[ks], s0, 0, 0, 0); \
            s1 = __builtin_amdgcn_mfma_f32_32x32x16_bf16(k1, qf[ks], s1, 0, 0, 0); } \
        float mx = fmaxf(s0[0], s1[0]); \
        _Pragma("unroll") for (int r = 1; r < 16; ++r) mx = fmaxf(mx, fmaxf(s0[r], s1[r])); \
        mx = fmaxf(mx, __shfl_xor(mx, 32)); \
        const float mnew = fmaxf(mrun, mx); \
        const float alpha = fexp2(mrun - mnew); \
        mrun = mnew; \
        float ls = 0.f; \
        _Pragma("unroll") for (int r = 0; r < 16; ++r) { s0[r] = fexp2(s0[r] - mnew); s1[r] = fexp2(s1[r] - mnew); ls += s0[r] + s1[r]; } \
        lrun = lrun * alpha + ls; \
        if (__any(alpha != 1.f)) { \
            _Pragma("unroll") for (int r = 0; r < 16; ++r) { o0[r] *= alpha; o1[r] *= alpha; } } \
        _Pragma("unroll") for (int s2 = 0; s2 < 4; ++s2) { \
            const int rb = 8 * (s2 & 1); \
            bf16x8 pf; \
            if (s2 < 2) pf = mk8(pack2(s0[rb + 0], s0[rb + 1]), pack2(s0[rb + 2], s0[rb + 3]), pack2(s0[rb + 4], s0[rb + 5]), pack2(s0[rb + 6], s0[rb + 7])); \
            else pf = mk8(pack2(s1[rb + 0], s1[rb + 1]), pack2(s1[rb + 2], s1[rb + 3]), pack2(s1[rb + 4], s1[rb + 5]), pack2(s1[rb + 6], s1[rb + 7])); \
            const unsigned char* va = cur + vfo + (16 * s2) * 2; \
            const uint2 a0 = *(const uint2*)va, a1 = *(const uint2*)(va + 16); \
            const uint2 b0 = *(const uint2*)(va + 32 * AT_VROW), b1 = *(const uint2*)(va + 32 * AT_VROW + 16); \
            o0 = __builtin_amdgcn_mfma_f32_32x32x16_bf16(mk8(a0.x, a0.y, a1.x, a1.y), pf, o0, 0, 0, 0); \
            o1 = __builtin_amdgcn_mfma_f32_32x32x16_bf16(mk8(b0.x, b0.y, b1.x, b1.y), pf, o1, 0, 0, 0); } }
    for (int j = 0; j < ntile; j += 3) {
        A_LOAD(r0, j + 3);
        A_COMPUTE(0);
        if (j + 1 < ntile) A_WRITE(r1, 1);
        __syncthreads();
        A_LOAD(r1, j + 4);
        if (j + 1 < ntile) A_COMPUTE(1);
        if (j + 2 < ntile) A_WRITE(r2, 2);
        __syncthreads();
        A_LOAD(r2, j + 5);
        if (j + 2 < ntile) A_COMPUTE(2);
        if (j + 3 < ntile) A_WRITE(r0, 0);
        __syncthreads();
    }
    asm volatile("s_waitcnt vmcnt(0)" ::: "memory");
#undef A_LOAD
#undef A_WRITE
#undef A_COMPUTE
    const float ltot = lrun + __shfl_xor(lrun, 32);
    const float inv = 1.f / ltot;
    bf16_t* dst = (bf16_t*)(p->ws + WS_HM) + (size_t)m * 1024 + h * 64;
#pragma unroll
    for (int g = 0; g < 4; ++g) {
        uint2 v; v.x = pack2(o0[4 * g] * inv, o0[4 * g + 1] * inv); v.y = pack2(o0[4 * g + 2] * inv, o0[4 * g + 3] * inv);
        *(uint2*)(dst + 8 * g + 4 * half) = v;
        uint2 u; u.x = pack2(o1[4 * g] * inv, o1[4 * g + 1] * inv); u.y = pack2(o1[4 * g + 2] * inv, o1[4 * g + 3] * inv);
        *(uint2*)(dst + 32 + 8 * g + 4 * half) = u;
    }
}

constexpr int RT_KROW = 144, RT_VROW = 264, RT_SROW = 144;
constexpr int RT_KOFF = 0, RT_VOFF = 128 * RT_KROW, RT_SFOFF = RT_VOFF + 64 * RT_VROW, RT_SBOFF = RT_SFOFF + 64 * RT_SROW;
__device__ __forceinline__ void ret_item(PP p, int l, int rit, unsigned char* smem) {
    const int c = rit >> 2, h = rit & 3;
    const int t = opaque_tid(), lane = t & 63, w = t >> 6, half = lane >> 5, ql = lane & 31;
    const bool ctx = c < 64;
    int b, ci, n, cbase;
    if (ctx) { b = c >> 1; ci = c & 1; n = 2; cbase = c - ci; }
    else { const int c2 = c - 64; b = c2 >> 4; ci = c2 & 15; n = 16; cbase = c - ci; }
    const bf16_t* PROJ = (const bf16_t*)(p->ws + WS_PROJ);
    const float lgf = log_sigmoid(p->in[19][l * 4 + h]), lgb = log_sigmoid(p->in[20][l * 4 + h]);
    const float cf = expf(lgf * 128.f), cb = expf(lgb * 128.f);
    const float lgf2 = lgf * 1.4426950408889634f, lgb2 = lgb * 1.4426950408889634f;
#pragma unroll
    for (int i = 0; i < 4; ++i) {
        const int idx = t + 256 * i, a = idx >> 3, cc = idx & 7;
        const bf16_t* pr = PROJ + (size_t)(c * 128 + a) * INC + h * 64 + cc * 8;
        const uint4 kv = *(const uint4*)(pr + 1440), vv = *(const uint4*)(pr + 1696);
        *(uint4*)(smem + RT_KOFF + a * RT_KROW + cc * 16) = kv;
        bf16_t* vt = (bf16_t*)(smem + RT_VOFF) + a;
        const int d0 = cc * 8;
        vt[(d0 + 0) * (RT_VROW / 2)] = (bf16_t)(vv.x & 0xffffu); vt[(d0 + 1) * (RT_VROW / 2)] = (bf16_t)(vv.x >> 16);
        vt[(d0 + 2) * (RT_VROW / 2)] = (bf16_t)(vv.y & 0xffffu); vt[(d0 + 3) * (RT_VROW / 2)] = (bf16_t)(vv.y >> 16);
        vt[(d0 + 4) * (RT_VROW / 2)] = (bf16_t)(vv.z & 0xffffu); vt[(d0 + 5) * (RT_VROW / 2)] = (bf16_t)(vv.z >> 16);
        vt[(d0 + 6) * (RT_VROW / 2)] = (bf16_t)(vv.w & 0xffffu); vt[(d0 + 7) * (RT_VROW / 2)] = (bf16_t)(vv.w >> 16);
    }
    {
        const int e0 = t * 16, dk = e0 >> 6, dv0 = e0 & 63;
        const float* U = (const float*)(p->ws + WS_U);
        float sf[16], sb[16];
        if (ctx) {
#pragma unroll
            for (int j = 0; j < 16; ++j) { sf[j] = 0.f; sb[j] = 0.f; }
        } else {
            const float* s0f = p->in[4] + ((size_t)(((b * 2 + l) * 2 + 0) * 4 + h)) * 4096 + e0;
            const float* s0b = p->in[4] + ((size_t)(((b * 2 + l) * 2 + 1) * 4 + h)) * 4096 + e0;
#pragma unroll
            for (int j = 0; j < 16; j += 4) {
                const float4 a = *(const float4*)(s0f + j), bb = *(const float4*)(s0b + j);
                sf[j] = a.x; sf[j + 1] = a.y; sf[j + 2] = a.z; sf[j + 3] = a.w;
                sb[j] = bb.x; sb[j + 1] = bb.y; sb[j + 2] = bb.z; sb[j + 3] = bb.w;
            }
        }
        for (int jb = 0; jb < ci; jb += 4) {
            float4 ua[4][4];
#pragma unroll
            for (int k = 0; k < 4; ++k) {
                const int jj = jb + k < ci ? jb + k : ci - 1;
                const float* u = U + (size_t)(((cbase + jj) * 4 + h) * 2 + 0) * 4096 + e0;
#pragma unroll
                for (int q = 0; q < 4; ++q) ua[k][q] = *(const float4*)(u + 4 * q);
            }
#pragma unroll
            for (int k = 0; k < 4; ++k)
                if (jb + k < ci) {
#pragma unroll
                    for (int q = 0; q < 4; ++q) { sf[4 * q] = cf * sf[4 * q] + ua[k][q].x; sf[4 * q + 1] = cf * sf[4 * q + 1] + ua[k][q].y; sf[4 * q + 2] = cf * sf[4 * q + 2] + ua[k][q].z; sf[4 * q + 3] = cf * sf[4 * q + 3] + ua[k][q].w; }
                }
        }
        {
            const int cnt = n - 1 - ci;
            for (int jb = 0; jb < cnt; jb += 4) {
                float4 ua[4][4];
#pragma unroll
                for (int k = 0; k < 4; ++k) {
                    const int jj = jb + k < cnt ? n - 1 - (jb + k) : ci + 1;
                    const float* u = U + (size_t)(((cbase + jj) * 4 + h) * 2 + 1) * 4096 + e0;
#pragma unroll
                    for (int q = 0; q < 4; ++q) ua[k][q] = *(const float4*)(u + 4 * q);
                }
#pragma unroll
                for (int k = 0; k < 4; ++k)
                    if (jb + k < cnt) {
#pragma unroll
                        for (int q = 0; q < 4; ++q) { sb[4 * q] = cb * sb[4 * q] + ua[k][q].x; sb[4 * q + 1] = cb * sb[4 * q + 1] + ua[k][q].y; sb[4 * q + 2] = cb * sb[4 * q + 2] + ua[k][q].z; sb[4 * q + 3] = cb * sb[4 * q + 3] + ua[k][q].w; }
                    }
            }
        }
        if (ctx) {
            if (ci == n - 1) {
                const float* u = U + (size_t)((c * 4 + h) * 2 + 0) * 4096 + e0;
                float* o = p->out + OUT_ST + ((size_t)(((b * 2 + l) * 2 + 0) * 4 + h)) * 4096 + e0;
#pragma unroll
                for (int j = 0; j < 16; j += 4) { const float4 a = *(const float4*)(u + j); *(float4*)(o + j) = make_float4(cf * sf[j] + a.x, cf * sf[j + 1] + a.y, cf * sf[j + 2] + a.z, cf * sf[j + 3] + a.w); }
            }
            if (ci == 0) {
                const float* u = U + (size_t)((c * 4 + h) * 2 + 1) * 4096 + e0;
                float* o = p->out + OUT_ST + ((size_t)(((b * 2 + l) * 2 + 1) * 4 + h)) * 4096 + e0;
#pragma unroll
                for (int j = 0; j < 16; j += 4) { const float4 a = *(const float4*)(u + j); *(float4*)(o + j) = make_float4(cb * sb[j] + a.x, cb * sb[j + 1] + a.y, cb * sb[j + 2] + a.z, cb * sb[j + 3] + a.w); }
            }
        }
        bf16_t* sF = (bf16_t*)(smem + RT_SFOFF) + dk; bf16_t* sB = (bf16_t*)(smem + RT_SBOFF) + dk;
#pragma unroll
        for (int j = 0; j < 16; j += 2) {
            const unsigned pf = pack2(sf[j], sf[j + 1]), pb = pack2(sb[j], sb[j + 1]);
            sF[(dv0 + j) * (RT_SROW / 2)] = (bf16_t)(pf & 0xffffu); sF[(dv0 + j + 1) * (RT_SROW / 2)] = (bf16_t)(pf >> 16);
            sB[(dv0 + j) * (RT_SROW / 2)] = (bf16_t)(pb & 0xffffu); sB[(dv0 + j + 1) * (RT_SROW / 2)] = (bf16_t)(pb >> 16);
        }
    }
    const int a = w * 32 + ql;
    const int m = c * 128 + a;
    bf16x8 qf[4];
    {
        const bf16_t* qsrc = PROJ + (size_t)m * INC + 1184 + h * 64 + half * 8;
#pragma unroll
        for (int ks = 0; ks < 4; ++ks) { const uint4 u = *(const uint4*)(qsrc + ks * 16); qf[ks] = mk8(u.x, u.y, u.z, u.w); }
    }
    __syncthreads();
    f32x16 o0, o1;
    {
        f32x16 f0, f1;
#pragma unroll
        for (int r = 0; r < 16; ++r) { f0[r] = 0.f; f1[r] = 0.f; }
#pragma unroll
        for (int ks = 0; ks < 4; ++ks) {
            const int ko = (ks * 16 + half * 8) * 2;
            const bf16x8 sf0 = *(const bf16x8*)(smem + RT_SFOFF + ql * RT_SROW + ko), sf1 = *(const bf16x8*)(smem + RT_SFOFF + (32 + ql) * RT_SROW + ko);
            f0 = __builtin_amdgcn_mfma_f32_32x32x16_bf16(sf0, qf[ks], f0, 0, 0, 0);
            f1 = __builtin_amdgcn_mfma_f32_32x32x16_bf16(sf1, qf[ks], f1, 0, 0, 0);
        }
        const float wf = fexp2(lgf2 * (float)(a + 1));
#pragma unroll
        for (int r = 0; r < 16; ++r) { o0[r] = wf * f0[r]; o1[r] = wf * f1[r]; }
#pragma unroll
        for (int r = 0; r < 16; ++r) { f0[r] = 0.f; f1[r] = 0.f; }
#pragma unroll
        for (int ks = 0; ks < 4; ++ks) {
            const int ko = (ks * 16 + half * 8) * 2;
            const bf16x8 sb0 = *(const bf16x8*)(smem + RT_SBOFF + ql * RT_SROW + ko), sb1 = *(const bf16x8*)(smem + RT_SBOFF + (32 + ql) * RT_SROW + ko);
            f0 = __builtin_amdgcn_mfma_f32_32x32x16_bf16(sb0, qf[ks], f0, 0, 0, 0);
            f1 = __builtin_amdgcn_mfma_f32_32x32x16_bf16(sb1, qf[ks], f1, 0, 0, 0);
        }
        const float wb = fexp2(lgb2 * (float)(128 - a));
#pragma unroll
        for (int r = 0; r < 16; ++r) { o0[r] += wb * f0[r]; o1[r] += wb * f1[r]; }
    }
#pragma unroll 1
    for (int kt2 = 0; kt2 < 4; ++kt2) {
        f32x16 s;
#pragma unroll
        for (int r = 0; r < 16; ++r) s[r] = 0.f;
#pragma unroll
        for (int ks = 0; ks < 4; ++ks) {
            const bf16x8 kf = *(const bf16x8*)(smem + RT_KOFF + (kt2 * 32 + ql) * RT_KROW + (ks * 16 + half * 8) * 2);
            s = __builtin_amdgcn_mfma_f32_32x32x16_bf16(kf, qf[ks], s, 0, 0, 0);
        }
#pragma unroll
        for (int r = 0; r < 16; ++r) {
            const int ap = kt2 * 32 + (r & 3) + 8 * (r >> 2) + 4 * half;
            const int d = a - ap;
            const float dec = d > 0 ? fexp2(lgf2 * (float)d) : (d < 0 ? fexp2(lgb2 * (float)(-d)) : 2.f);
            s[r] = s[r] * dec * 0.125f;
        }
#pragma unroll
        for (int s2 = 0; s2 < 2; ++s2) {
            const int rb = 8 * s2;
            const bf16x8 pf = mk8(pack2(s[rb + 0], s[rb + 1]), pack2(s[rb + 2], s[rb + 3]), pack2(s[rb + 4], s[rb + 5]), pack2(s[rb + 6], s[rb + 7]));
            const int keyb = kt2 * 32 + 16 * s2 + 4 * half;
            const unsigned char* va = smem + RT_VOFF + ql * RT_VROW + keyb * 2;
            const uint2 a0 = *(const uint2*)va, a1 = *(const uint2*)(va + 16);
            const uint2 b0 = *(const uint2*)(va + 32 * RT_VROW), b1 = *(const uint2*)(va + 32 * RT_VROW + 16);
            o0 = __builtin_amdgcn_mfma_f32_32x32x16_bf16(mk8(a0.x, a0.y, a1.x, a1.y), pf, o0, 0, 0, 0);
            o1 = __builtin_amdgcn_mfma_f32_32x32x16_bf16(mk8(b0.x, b0.y, b1.x, b1.y), pf, o1, 0, 0, 0);
        }
    }
    float ss = 0.f;
#pragma unroll
    for (int r = 0; r < 16; ++r) ss += o0[r] * o0[r] + o1[r] * o1[r];
    ss += __shfl_xor(ss, 32);
    const float rs = rsqrtf(ss * (1.f / 64.f) + EPS);
    const bf16_t* rg = PROJ + (size_t)m * INC + 1952 + h * 64;
    bf16_t* dst = (bf16_t*)(p->ws + WS_HM) + (size_t)m * 1024 + 768 + h * 64;
#pragma unroll
    for (int g = 0; g < 4; ++g) {
#pragma unroll
        for (int dt = 0; dt < 2; ++dt) {
            const int dv = dt * 32 + 8 * g + 4 * half;
            const uint2 gv = *(const uint2*)(rg + dv);
            const float g0 = bflo(gv.x), g1 = bfhi(gv.x), g2 = bflo(gv.y), g3 = bfhi(gv.y);
            const float x0 = dt ? o1[4 * g] : o0[4 * g], x1 = dt ? o1[4 * g + 1] : o0[4 * g + 1], x2 = dt ? o1[4 * g + 2] : o0[4 * g + 2], x3 = dt ? o1[4 * g + 3] : o0[4 * g + 3];
            uint2 v;
            v.x = pack2(x0 * rs * (g0 * __builtin_amdgcn_rcpf(1.f + __expf(-g0))), x1 * rs * (g1 * __builtin_amdgcn_rcpf(1.f + __expf(-g1))));
            v.y = pack2(x2 * rs * (g2 * __builtin_amdgcn_rcpf(1.f + __expf(-g2))), x3 * rs * (g3 * __builtin_amdgcn_rcpf(1.f + __expf(-g3))));
            *(uint2*)(dst + dv) = v;
        }
    }
    __syncthreads();
}

constexpr int NPHASE = 19;
__device__ __forceinline__ void run_phase(PP p, int ph, unsigned char* smem) {
    const int vb = opaque_tid_full() >> 8;
    const int G = 2 * gridDim.x, bid = 2 * opaque_bid() + vb;
    unsigned char* vsm = smem + vb * VSMEM;
    if (ph == 0) {
        if (bid < 384) mod_item(p, bid, vsm);
        else { for (int j = 0; j < 10; ++j) conv_item(p, 0, (bid - 384) * 10 + j, vsm); }
        for (int it = 1280 + bid; it < CONV_ITEMS; it += G) conv_item(p, 0, it, vsm);
        return;
    }
    const int l = (ph - 1) / 9, s = (ph - 1) % 9;
    float* MOD = (float*)(p->ws + WS_MOD);
    bf16_t* HM = (bf16_t*)(p->ws + WS_HM);
    Epi ep; ep.obf = nullptr; ep.ldc = 0; ep.ncols = 0; ep.X = p->out; ep.xs0 = p->out; ep.xs1 = p->out + (size_t)8192 * 1024; ep.gate = MOD; ep.proj = nullptr; ep.ckpe = nullptr; ep.lyr = l;
    switch (s) {
    case 0: {
        const int nconv = l == 0 ? 0 : CONV_ITEMS;
        for (int it = bid; it < 2048 + nconv; it += G) {
            if (it < 2048) norm_item(p, l, it, 0); else conv_item(p, l, it - 2048, vsm);
        }
    } break;
    case 1: {
        ep.obf = (bf16_t*)(p->ws + WS_PROJ); ep.ldc = INC; ep.ncols = INC;
        gemm_phase<EPI_BF16, true, 3>(HM, 1024, (const bf16_t*)(p->ws + WS_WIN), 1024, NTOK, 2304, 1024, ep, smem);
    } break;
    case 2: {
        for (int it = bid; it < 512; it += G) phaseC_item(p, l, it, vsm);
    } break;
    case 3: {
        ep.obf = (bf16_t*)(p->ws + WS_QRAW); ep.ldc = 768; ep.ncols = 768;
        gemm_phase<EPI_BF16, false>((const bf16_t*)(p->ws + WS_PROJ), INC, (const bf16_t*)(p->ws + WS_WQUP), 256, NTOK, 768, 256, ep, smem);
        ep.obf = (bf16_t*)(p->ws + WS_KB); ep.gate = p->in[17] + l * 96; ep.proj = (const bf16_t*)(p->ws + WS_PROJ); ep.ckpe = p->in[3]; ep.lyr = l;
        gemm_phase<EPI_KHEAD, false>((const bf16_t*)(p->ws + WS_CKV), 128, (const bf16_t*)(p->ws + WS_WKV), 128, NKV, 512, 128, ep, smem, 0, 8);
        ep.obf = (bf16_t*)(p->ws + WS_VT); ep.ldc = NKV; ep.ncols = 512;
        gemm_phase<EPI_VT, false>((const bf16_t*)(p->ws + WS_CKV), 128, (const bf16_t*)(p->ws + WS_WKV) + (size_t)512 * 128, 128, NKV, 512, 128, ep, smem, 0, 22);
    } break;
    case 4: {
        for (int it = bid; it < 1536; it += G) {
            if (it >= 512 && it < 1024) ret_item(p, l, it - 512, vsm);
            else attn_item(p, l, it < 512 ? it : it - 512, vsm);
        }
    } break;
    case 5: {
        if (l == 0) { ep.xs0 = p->in[0]; ep.xs1 = p->in[1]; }
        ep.gate = MOD + l * 5 * 6144 + 2 * 1024;
        gemm_phase<EPI_RESID>(HM, 1024, (const bf16_t*)(p->ws + WS_WO), 1024, NTOK, 1024, 1024, ep, smem);
    } break;
    case 6: {
        for (int it = bid; it < 2048; it += G) norm_item(p, l, it, 1);
    } break;
    case 7: {
        ep.obf = (bf16_t*)(p->ws + WS_ACT); ep.ldc = FFH; ep.ncols = FFH;
        gemm_phase<EPI_SWIGLU, true, 4, 8>(HM, 1024, (const bf16_t*)(p->ws + WS_WGU), 1024, NTOK, 5632, 1024, ep, smem, 1);
        gemm_phase<EPI_SWIGLU, true, 4, 4>(HM, 1024, (const bf16_t*)(p->ws + WS_WGU), 1024, NTOK, 5632, 1024, ep, smem, 2);
    } break;
    case 8: {
        ep.gate = MOD + l * 5 * 6144 + 5 * 1024;
        gemm_phase<EPI_RESID>((const bf16_t*)(p->ws + WS_ACT), FFH, (const bf16_t*)(p->ws + WS_WDN), FFH, NTOK, 1024, FFH, ep, smem);
    } break;
    }
}

__global__ void __launch_bounds__(512, 2) mk_forward(Params p_arg, int ph_lo, int ph_hi) {
    __shared__ __attribute__((aligned(16))) unsigned char smem[SMEM_BYTES];
    PP p = (PP)__builtin_amdgcn_kernarg_segment_ptr();
    volatile LAS unsigned* st = (volatile LAS unsigned*)(smem + SMEM_BYTES - 16);
    const bool multi = (ph_hi - ph_lo) > 1;
    if (multi) {
        if (opaque_tid_full() == 0) { st[0] = 0u; st[1] = 0u; st[2] = 0u; st[3] = 0u; }
        __syncthreads();
        (void)xcd_barrier_post((unsigned*)(p->ws + WS_BAR), st);
    }
#define MK_PH(N) \
    if ((N) >= ph_lo && (N) < ph_hi) { \
        if ((N) > ph_lo) { \
            if (ph_lo > 4096) { __syncthreads(); cg::this_grid().sync(); }     \
            asm volatile("" : "+s"(p)); \
            XcdBarrier xb; xb.bar = (unsigned*)(p->ws + WS_BAR); xb.x = xb_xcc_id(); xb.st = st; \
            xcd_barrier(xb); \
        } \
        asm volatile("" : "+s"(p)); \
        run_phase(p, (N), smem); \
    }
    MK_PH(0) MK_PH(1) MK_PH(2) MK_PH(3) MK_PH(4) MK_PH(5) MK_PH(6) MK_PH(7) MK_PH(8) MK_PH(9)
    MK_PH(10) MK_PH(11) MK_PH(12) MK_PH(13) MK_PH(14) MK_PH(15) MK_PH(16) MK_PH(17) MK_PH(18)
#undef MK_PH
}

extern "C" void kernel_launch(void* const* d_in, const int* in_sizes, int n_in, void* d_out, int out_size, void* d_ws, size_t ws_size, hipStream_t stream) {
    Params p{};
    for (int i = 0; i < 25; ++i) p.in[i] = (const float*)d_in[i];
    p.out = (float*)d_out;
    p.ws = (unsigned char*)d_ws;
    static int grid_blocks = 0;
    if (!grid_blocks) {
        int dev = 0, cus = 0, per_cu = 0;
        hipGetDevice(&dev);
        hipDeviceGetAttribute(&cus, hipDeviceAttributeMultiprocessorCount, dev);
        hipOccupancyMaxActiveBlocksPerMultiprocessor(&per_cu, mk_forward, 512, 0);
        if (per_cu > 1) per_cu = 1;
        if (per_cu < 1) per_cu = 1;
        grid_blocks = cus * per_cu;
    }
    hipMemsetAsync((unsigned char*)d_ws + WS_BAR, 0, 16384, stream);
#if MK_MULTI
    for (int ph = 0; ph < NPHASE; ++ph) hipLaunchKernelGGL(mk_forward, dim3(grid_blocks), dim3(512), 0, stream, p, ph, ph + 1);
#else
    int lo = 0, hi = NPHASE;
    void* args[] = {&p, &lo, &hi};
    hipError_t e = hipLaunchCooperativeKernel((const void*)mk_forward, dim3(grid_blocks), dim3(512), args, 0, stream);
    if (e != hipSuccess) fprintf(stderr, "cooperative launch failed: %s (grid %d)\n", hipGetErrorString(e), grid_blocks);
#endif
}
```
